# Optimizing an MI355X kernel written in HIP

```python
import math
import jax, jax.numpy as jnp
from jax import lax
import numpy as np

D_MODEL = 1024
BATCH = 32
SEQ = 256
DEPTH = 2
DEC_BATCH = 8
DEC_SEQ = 2048
PAST_LEN = 256

GRID_W = 64
Q_BLOCK = 128
EPS = 1e-6
ROPE_BASE = 10000.0
A_HEADS = 8
A_KV = 2
A_GROUP = A_HEADS // A_KV
HEAD_DIM = 64
M_HEADS = 4
M_Q_RANK = 256
M_KV_RANK = 128
M_NOPE = 64
M_ROPE = 32
M_V = 64
C_GROUPS = 4
C_DIM = 64
C_CHUNK = 128
A_Q_W = A_HEADS * HEAD_DIM
A_KV_W = A_KV * HEAD_DIM
C_W = C_GROUPS * C_DIM
IN_SIZES = [A_Q_W, A_KV_W, A_KV_W, M_Q_RANK, M_KV_RANK, M_ROPE, C_W, C_W]
IN_SPLITS = [int(v) for v in np.cumsum(IN_SIZES)[:-1]]
IN_W = int(sum(IN_SIZES))
MIX_W = A_HEADS * HEAD_DIM + M_HEADS * M_V + C_W
PEER_HEADS = 8
N_KEYS = 128
N_EXPERTS = N_KEYS * N_KEYS
PEER_DK = 256
PEER_HALF = PEER_DK // 2
PEER_TOPK = 16
ALPHA = (2.0 * DEPTH) ** 0.25
BETA = (8.0 * DEPTH) ** -0.25

kernel_name = "hybrid_diffusion_gqa_mla_gmlp_peer_step"


def _ln(x, g=None, b=None):
    xf = x.astype(jnp.float32)
    mu = jnp.mean(xf, axis=-1, keepdims=True)
    var = jnp.mean(jnp.square(xf - mu), axis=-1, keepdims=True)
    y = (xf - mu) * lax.rsqrt(var + EPS)
    if g is not None:
        y = y * g.astype(jnp.float32) + b.astype(jnp.float32)
    return y.astype(x.dtype)


def _rms(x, g):
    xf = x.astype(jnp.float32)
    y = xf * lax.rsqrt(jnp.mean(jnp.square(xf), axis=-1, keepdims=True) + EPS) * g.astype(jnp.float32)
    return y.astype(x.dtype)


def _rot(x, ang):
    m = ang.shape[-1]
    c = jnp.cos(ang)[None, :, None, :]
    s = jnp.sin(ang)[None, :, None, :]
    x1, x2 = x[..., :m], x[..., m:]
    return jnp.concatenate([x1 * c - x2 * s, x1 * s + x2 * c], axis=-1)


def axial_rope(x):
    S, d = x.shape[1], x.shape[-1]
    rows = S // GRID_W
    m = d // 4
    row_idx = jnp.repeat(jnp.arange(rows), GRID_W).astype(jnp.float32)
    col_idx = jnp.tile(jnp.arange(GRID_W), rows).astype(jnp.float32)
    freqs = ROPE_BASE ** (-jnp.arange(m, dtype=jnp.float32) / m)
    xf = x.astype(jnp.float32)
    out = jnp.concatenate([_rot(xf[..., :2 * m], row_idx[:, None] * freqs),
                           _rot(xf[..., 2 * m:], col_idx[:, None] * freqs)], axis=-1)
    return out.astype(x.dtype)


def block_attention(q, k, v):
    B, Sq, Hk, G, dk = q.shape
    dv = v.shape[-1]
    nb = Sq // Q_BLOCK
    qb = jnp.moveaxis(q.reshape(B, nb, Q_BLOCK, Hk, G, dk), 1, 0)
    scale = 1.0 / math.sqrt(dk)

    def one(qblk):
        s = jnp.einsum('bqhgd,bkhd->bhgqk', qblk, k).astype(jnp.float32) * scale
        p = jax.nn.softmax(s, axis=-1).astype(v.dtype)
        return jnp.einsum('bhgqk,bkhe->bqhge', p, v)

    o = lax.map(one, qb)
    return jnp.moveaxis(o, 0, 1).reshape(B, Sq, Hk * G * dv)


def chunk_gmlp(u, v, w_s, b_s):
    B, S, _ = u.shape
    vg = _ln(v.reshape(B, S // C_CHUNK, C_CHUNK, C_GROUPS, C_DIM))
    mixed = jnp.einsum('gpq,bnqgd->bnpgd', w_s, vg) + b_s.T[None, None, :, :, None]
    return u * mixed.reshape(B, S, C_GROUPS * C_DIM)


def peer(h, w_q, k1, k2, u_tab, v_tab):
    B, S, D = h.shape
    xt = h.reshape(-1, Q_BLOCK, D)

    def one(xb):
        q = (xb @ w_q).reshape(Q_BLOCK, PEER_HEADS, 2, PEER_HALF)
        s1 = jnp.einsum('thd,nd->thn', q[:, :, 0], k1)
        s2 = jnp.einsum('thd,nd->thn', q[:, :, 1], k2)
        v1, i1 = lax.top_k(s1, PEER_TOPK)
        v2, i2 = lax.top_k(s2, PEER_TOPK)
        cand = (v1[..., :, None] + v2[..., None, :]).reshape(Q_BLOCK, PEER_HEADS, PEER_TOPK * PEER_TOPK)
        cidx = (i1[..., :, None] * N_KEYS + i2[..., None, :]).reshape(Q_BLOCK, PEER_HEADS, PEER_TOPK * PEER_TOPK)
        top, pos = lax.top_k(cand, PEER_TOPK)
        idx = jnp.take_along_axis(cidx, pos, axis=-1)
        g = jax.nn.softmax(top.astype(jnp.float32), axis=-1).astype(xb.dtype)
        a = jax.nn.gelu(jnp.einsum('thkd,td->thk', u_tab[idx], xb))
        return jnp.einsum('thk,thkd->td', g * a, v_tab[idx])

    return lax.map(one, xt).reshape(B, S, D)


def _layer(x, mod, P, cache):
    B, S, _ = x.shape
    sh1, sc1, g1, sh2, sc2, g2 = jnp.split(mod[:, None, :], 6, axis=-1)
    h = _ln(x) * (1 + sc1) + sh1
    q_a, k_a, v_a, cq, ckv, krope, u_c, v_c = jnp.split(h @ P['w_in'], IN_SPLITS, axis=-1)
    q_a = _rms(q_a.reshape(B, S, A_HEADS, HEAD_DIM), P['aqn'])
    k_a = _rms(k_a.reshape(B, S, A_KV, HEAD_DIM), P['akn'])
    v_a = v_a.reshape(B, S, A_KV, HEAD_DIM)
    cq = _rms(cq, P['mqn'])
    ckv = _rms(ckv, P['mkvn'])
    qm = (cq @ P['w_uq']).reshape(B, S, M_HEADS, M_NOPE + M_ROPE)
    qm_nope, qm_rope = qm[..., :M_NOPE], qm[..., M_NOPE:]
    if cache is None:
        new = (k_a, v_a, ckv, krope)
    else:
        new = None
        c_k, c_v, c_ckv, c_krope = cache
        q_a = axial_rope(q_a)
        qm_rope = axial_rope(qm_rope)
        k_a = jnp.concatenate([c_k, axial_rope(k_a)], axis=1)
        v_a = jnp.concatenate([c_v, v_a], axis=1)
        ckv = jnp.concatenate([c_ckv, ckv], axis=1)
        krope = jnp.concatenate([c_krope, axial_rope(krope[:, :, None, :])[:, :, 0]], axis=1)
    L = ckv.shape[1]
    kv = (ckv @ P['w_ukv']).reshape(B, L, M_HEADS, M_NOPE + M_V)
    k_m = jnp.concatenate([kv[..., :M_NOPE],
                           jnp.broadcast_to(krope[:, :, None, :], (B, L, M_HEADS, M_ROPE))], axis=-1)
    v_m = kv[..., M_NOPE:]
    q_m = jnp.concatenate([qm_nope, qm_rope], axis=-1)
    o_a = block_attention(q_a.reshape(B, S, A_KV, A_GROUP, HEAD_DIM), k_a, v_a)
    o_m = block_attention(q_m[:, :, :, None, :], k_m, v_m)
    o_c = chunk_gmlp(u_c, v_c, P['ws'], P['bs'])
    mix = jnp.concatenate([o_a, o_m, o_c], axis=-1) @ P['w_o']
    x = _ln(ALPHA * x + g1 * mix, P['ln1_g'], P['ln1_b'])
    h2 = _ln(x) * (1 + sc2) + sh2
    ff = peer(h2, P['pwq'], P['pk1'], P['pk2'], P['pu'], P['pv'])
    x = _ln(ALPHA * x + g2 * ff, P['ln2_g'], P['ln2_b'])
    return x, new


def setup_inputs(seed: int = 0) -> dict:
    key = jax.random.key(seed)
    ks = jax.random.split(key, 32)
    f32 = jnp.float32

    def nrm(k, shape, s):
        return jax.random.normal(k, shape, f32) * s

    D = D_MODEL
    return {
        "x_prompt": nrm(ks[0], (BATCH, SEQ, D), 1.0),
        "x_sample": nrm(ks[1], (DEC_BATCH, DEC_SEQ, D), 1.0),
        "cache_attn_k": nrm(ks[2], (DEC_BATCH, DEPTH, PAST_LEN, A_KV, HEAD_DIM), 1.0),
        "cache_attn_v": nrm(ks[3], (DEC_BATCH, DEPTH, PAST_LEN, A_KV, HEAD_DIM), 1.0),
        "cache_mla_ckv": nrm(ks[4], (DEC_BATCH, DEPTH, PAST_LEN, M_KV_RANK), 1.0),
        "cache_mla_krope": nrm(ks[5], (DEC_BATCH, DEPTH, PAST_LEN, M_ROPE), 1.0),
        "c": nrm(ks[6], (DEC_BATCH, D), 1.0),
        "c_ctx": nrm(ks[7], (D,), 1.0),
        "w_mod": nrm(ks[8], (DEPTH, D, 6 * D), 0.5 * D ** -0.5),
        "b_mod": nrm(ks[9], (DEPTH, 6 * D), 0.02),
        "w_in": nrm(ks[10], (DEPTH, D, IN_W), D ** -0.5),
        "attn_q_norm": 1.0 + nrm(ks[11], (DEPTH, HEAD_DIM), 0.02),
        "attn_k_norm": 1.0 + nrm(ks[12], (DEPTH, HEAD_DIM), 0.02),
        "mla_q_norm": 1.0 + nrm(ks[13], (DEPTH, M_Q_RANK), 0.02),
        "mla_kv_norm": 1.0 + nrm(ks[14], (DEPTH, M_KV_RANK), 0.02),
        "w_uq": nrm(ks[15], (DEPTH, M_Q_RANK, M_HEADS * (M_NOPE + M_ROPE)), M_Q_RANK ** -0.5),
        "w_ukv": nrm(ks[16], (DEPTH, M_KV_RANK, M_HEADS * (M_NOPE + M_V)), M_KV_RANK ** -0.5),
        "gmlp_ws": nrm(ks[17], (DEPTH, C_GROUPS, C_CHUNK, C_CHUNK), C_CHUNK ** -0.5),
        "gmlp_b": 1.0 + nrm(ks[18], (DEPTH, C_GROUPS, C_CHUNK), 0.02),
        "w_o": nrm(ks[19], (DEPTH, MIX_W, D), BETA * MIX_W ** -0.5),
        "ln1_g": 1.0 + nrm(ks[20], (DEPTH, D), 0.02),
        "ln1_b": nrm(ks[21], (DEPTH, D), 0.02),
        "ln2_g": 1.0 + nrm(ks[22], (DEPTH, D), 0.02),
        "ln2_b": nrm(ks[23], (DEPTH, D), 0.02),
        "peer_wq": nrm(ks[24], (DEPTH, D, PEER_HEADS * PEER_DK), D ** -0.5),
        "peer_k1": nrm(ks[25], (DEPTH, N_KEYS, PEER_HALF), PEER_HALF ** -0.5),
        "peer_k2": nrm(ks[26], (DEPTH, N_KEYS, PEER_HALF), PEER_HALF ** -0.5),
        "peer_u": nrm(ks[27], (DEPTH, N_EXPERTS, D), D ** -0.5),
        "peer_v": nrm(ks[28], (DEPTH, N_EXPERTS, D), BETA * PEER_HEADS ** -0.5),
    }


def reference(x_prompt, x_sample, cache_attn_k, cache_attn_v, cache_mla_ckv, cache_mla_krope, c, c_ctx,
              w_mod, b_mod, w_in, attn_q_norm, attn_k_norm, mla_q_norm, mla_kv_norm, w_uq, w_ukv,
              gmlp_ws, gmlp_b, w_o, ln1_g, ln1_b, ln2_g, ln2_b, peer_wq, peer_k1, peer_k2, peer_u, peer_v):
    xp, xs = x_prompt, x_sample
    st_k, st_v, st_ckv, st_kr = [], [], [], []
    for l in range(DEPTH):
        P = {'w_in': w_in[l], 'aqn': attn_q_norm[l], 'akn': attn_k_norm[l], 'mqn': mla_q_norm[l],
             'mkvn': mla_kv_norm[l], 'w_uq': w_uq[l], 'w_ukv': w_ukv[l], 'ws': gmlp_ws[l], 'bs': gmlp_b[l],
             'w_o': w_o[l], 'ln1_g': ln1_g[l], 'ln1_b': ln1_b[l], 'ln2_g': ln2_g[l], 'ln2_b': ln2_b[l],
             'pwq': peer_wq[l], 'pk1': peer_k1[l], 'pk2': peer_k2[l], 'pu': peer_u[l], 'pv': peer_v[l]}
        mod_ctx = (jax.nn.silu(c_ctx) @ w_mod[l] + b_mod[l])[None]
        mod_lat = jax.nn.silu(c) @ w_mod[l] + b_mod[l]
        xp, (k_l, v_l, ckv_l, kr_l) = _layer(xp, mod_ctx, P, None)
        st_k.append(k_l)
        st_v.append(v_l)
        st_ckv.append(ckv_l)
        st_kr.append(kr_l)
        cache_l = (cache_attn_k[:, l], cache_attn_v[:, l], cache_mla_ckv[:, l], cache_mla_krope[:, l])
        xs, _ = _layer(xs, mod_lat, P, cache_l)
    new_attn_k = jnp.stack(st_k, axis=1)
    new_attn_v = jnp.stack(st_v, axis=1)
    new_mla_ckv = jnp.stack(st_ckv, axis=1)
    new_mla_krope = jnp.stack(st_kr, axis=1)
    return (xp, xs, new_attn_k, new_attn_v, new_mla_ckv, new_mla_krope)
```

```cpp
#include <hip/hip_runtime.h>
#include <hip/hip_cooperative_groups.h>
#include <cstdio>
#include <cstdint>
namespace cg = cooperative_groups;

typedef unsigned short u16;
typedef __bf16 bf16x2_t __attribute__((ext_vector_type(2)));
typedef float f32x2_t __attribute__((ext_vector_type(2)));
using bf16x8 = __attribute__((ext_vector_type(8))) short;
using f32x16 = __attribute__((ext_vector_type(16))) float;
using f32x4 = __attribute__((ext_vector_type(4))) float;
using u32x4 = __attribute__((ext_vector_type(4))) unsigned;
using u32x2 = __attribute__((ext_vector_type(2))) unsigned;
#define DI __device__ __forceinline__
#define MFMA32(a, b, c) __builtin_amdgcn_mfma_f32_32x32x16_bf16((a), (b), (c), 0, 0, 0)
#define MFMA16(a, b, c) __builtin_amdgcn_mfma_f32_16x16x32_bf16((a), (b), (c), 0, 0, 0)

constexpr int T = 24576, TC = 8192, NK = 26624, PLD = 1792;
constexpr int HP = 1088;
constexpr int WP = 1088;
constexpr int MP = 1056;
constexpr float LOG2E = 1.4426950408889634f;
constexpr float ALPHA = 1.4142135623730951f;
constexpr float EPS = 1e-6f;

struct Params {
  const float* x_prompt; const float* x_sample; const float* cache_k; const float* cache_v; const float* cache_ckv; const float* cache_kr;
  const float* c; const float* c_ctx; const float* w_mod; const float* b_mod; const float* w_in; const float* aqn; const float* akn;
  const float* mqn; const float* mkvn; const float* w_uq; const float* w_ukv; const float* gws; const float* gb; const float* w_o;
  const float* ln1g; const float* ln1b; const float* ln2g; const float* ln2b; const float* pwq; const float* pk1; const float* pk2;
  const float* pu; const float* pv;
  float* out; char* ws;
};

constexpr size_t al(size_t x) { return (x + 255) & ~(size_t)255; }
constexpr size_t OFF_MOD = 0;                        constexpr size_t SZ_MOD = (size_t)2 * 9 * 6144 * 4;
constexpr size_t OFF_BAR = OFF_MOD + SZ_MOD;          constexpr size_t SZ_BAR = (size_t)3456 * 4;
constexpr size_t OFF_R16 = al(OFF_BAR + SZ_BAR);
constexpr size_t OFF_R8 = al(OFF_R16 + 64 * 16 * 2 * 4);
constexpr size_t OFF_WIN = al(OFF_R8 + 64 * 8 * 2 * 4);
constexpr size_t OFF_WUQ = al(OFF_WIN + (size_t)2 * 1792 * WP * 2);
constexpr size_t OFF_WUKV = al(OFF_WUQ + (size_t)2 * 384 * 256 * 2);
constexpr size_t OFF_WO = al(OFF_WUKV + (size_t)2 * 512 * 128 * 2);
constexpr size_t OFF_PWQ = al(OFF_WO + (size_t)2 * 1024 * WP * 2);
constexpr size_t OFF_PK = al(OFF_PWQ + (size_t)2 * 2048 * WP * 2);
constexpr size_t OFF_GWS = al(OFF_PK + (size_t)2 * 2 * 128 * 128 * 2);
constexpr size_t OFF_PU = al(OFF_GWS + (size_t)2 * 4 * 128 * 128 * 2);
constexpr size_t OFF_PV = al(OFF_PU + (size_t)2 * 16384 * 1024);
constexpr size_t OFF_SU = al(OFF_PV + (size_t)2 * 16384 * 1024);
constexpr size_t OFF_SV = al(OFF_SU + (size_t)2 * 16384 * 4);
constexpr size_t OFF_H = al(OFF_SV + (size_t)2 * 16384 * 4);
constexpr size_t OFF_PROJ = al(OFF_H + (size_t)T * HP * 2);
constexpr size_t OFF_MIXOUT = OFF_PROJ;
constexpr size_t OFF_MIXIN = OFF_PROJ + (size_t)T * MP * 4;
constexpr size_t OFF_ATT = al(OFF_PROJ + (size_t)T * PLD * 4);
constexpr size_t OFF_QA = OFF_ATT;
constexpr size_t OFF_CQ = OFF_QA + (size_t)T * 512 * 2;
constexpr size_t OFF_UC = OFF_CQ + (size_t)T * 256 * 2;
constexpr size_t OFF_VGT = OFF_UC + (size_t)T * 256 * 2;
constexpr size_t OFF_QM = OFF_VGT + (size_t)T * 256 * 2;
constexpr size_t OFF_KA = OFF_QM + (size_t)T * 384 * 2;
constexpr size_t OFF_VAT = OFF_KA + (size_t)NK * 128 * 2;
constexpr size_t OFF_CKV = OFF_VAT + (size_t)NK * 128 * 2;
constexpr size_t OFF_KM = OFF_CKV + (size_t)NK * 128 * 2;
constexpr size_t OFF_VMT = OFF_KM + (size_t)NK * 384 * 2;
constexpr size_t OFF_ATT_END = OFF_VMT + (size_t)NK * 256 * 2;
constexpr size_t OFF_H2 = OFF_ATT;
constexpr size_t OFF_TOPK = OFF_ATT + (size_t)T * HP * 2;
constexpr size_t OFF_SIDX = OFF_TOPK + (size_t)T * 256 * 4;
constexpr size_t OFF_SW = OFF_SIDX + (size_t)T * 128 * 4;
constexpr size_t OFF_SSU = OFF_SW + (size_t)T * 128 * 4;
static_assert(OFF_SSU + (size_t)T * 128 * 4 <= OFF_ATT_END, "alias overflow 3");
constexpr size_t WS_NEED = OFF_ATT_END;
static_assert(OFF_TOPK + (size_t)T * 256 * 4 <= OFF_ATT_END, "alias overflow");
static_assert(OFF_MIXIN + (size_t)T * HP * 2 <= OFF_ATT, "alias overflow 2");

constexpr size_t OUT_K = (size_t)T * 1024;
constexpr size_t OUT_V = OUT_K + 2097152;
constexpr size_t OUT_CKV = OUT_V + 2097152;
constexpr size_t OUT_KR = OUT_CKV + 2097152;

constexpr int SMEM_BYTES = 36864;

DI int tid_opaque() { int t = threadIdx.x; asm volatile("" : "+v"(t)); return t; }
DI unsigned pk2(float a, float b) { f32x2_t v = {a, b}; bf16x2_t r = __builtin_convertvector(v, bf16x2_t); return __builtin_bit_cast(unsigned, r); }
DI float bflo(unsigned u) { return __uint_as_float(u << 16); }
DI float bfhi(unsigned u) { return __uint_as_float(u & 0xffff0000u); }
DI float wave_sum(float v) {
#pragma unroll
  for (int o = 32; o > 0; o >>= 1) v += __shfl_xor(v, o);
  return v;
}
DI float wave_max(float v) {
#pragma unroll
  for (int o = 32; o > 0; o >>= 1) v = fmaxf(v, __shfl_xor(v, o));
  return v;
}
DI const float* xin_row(const Params& p, int t) { return t < TC ? p.x_prompt + (size_t)t * 1024 : p.x_sample + (size_t)(t - TC) * 1024; }
DI int tok_modrow(int t) { return t < TC ? 0 : 1 + ((t - TC) >> 11); }
DI int tok_keyrow(int t) { if (t < TC) return t; int u = t - TC; return TC + (u >> 11) * 2304 + 256 + (u & 2047); }
DI size_t vt_index(int kr, int ch, int C) {
  if (kr < TC) return ((size_t)((kr >> 8) * C + ch)) * 256 + (kr & 255);
  int u = kr - TC; int bl = u / 2304; int pos = u - bl * 2304;
  return (size_t)32 * C * 256 + ((size_t)(bl * C + ch)) * 2304 + pos;
}
DI float gelu_tanh(float x) {
  float u = 0.7978845608028654f * (x + 0.044715f * x * x * x);
  float e = __expf(2.f * u);
  float th = 1.f - 2.f * __builtin_amdgcn_rcpf(e + 1.f);
  return 0.5f * x * (1.f + th);
}

DI void ln_stats16(const float (&x)[16], float& mu, float& rstd) {
  float s = 0.f;
#pragma unroll
  for (int i = 0; i < 16; ++i) s += x[i];
  s = wave_sum(s); mu = s * (1.f / 1024.f);
  float q = 0.f;
#pragma unroll
  for (int i = 0; i < 16; ++i) { float d = x[i] - mu; q += d * d; }
  q = wave_sum(q);
  rstd = rsqrtf(q * (1.f / 1024.f) + EPS);
}

DI void transpose_tile(const float* __restrict__ src, int N, u16* __restrict__ dst, int ldd, int k0, int n0, char* smem) {
  float* s = (float*)smem;
  const int tid = tid_opaque();
  __syncthreads();
#pragma unroll
  for (int it = 0; it < 4; ++it) {
    int kk = (tid >> 4) + 16 * it, cn = (tid & 15) * 4;
    f32x4 v = {0.f, 0.f, 0.f, 0.f};
    if (n0 + cn < N) v = *(const f32x4*)(src + (size_t)(k0 + kk) * N + n0 + cn);
    s[kk * 65 + cn + 0] = v[0]; s[kk * 65 + cn + 1] = v[1]; s[kk * 65 + cn + 2] = v[2]; s[kk * 65 + cn + 3] = v[3];
  }
  __syncthreads();
#pragma unroll
  for (int it = 0; it < 2; ++it) {
    int id = tid + 256 * it, n = id >> 3, kc = id & 7;
    if (n0 + n < N) {
      u32x4 o;
#pragma unroll
      for (int e = 0; e < 4; ++e) o[e] = pk2(s[(kc * 8 + 2 * e) * 65 + n], s[(kc * 8 + 2 * e + 1) * 65 + n]);
      *(u32x4*)(dst + (size_t)(n0 + n) * ldd + k0 + kc * 8) = o;
    }
  }
}

DI void convert_task(const float* __restrict__ src, u16* __restrict__ dst, size_t base) {
  const int tid = tid_opaque();
#pragma unroll
  for (int it = 0; it < 2; ++it) {
    size_t i = base + (size_t)(it * 256 + tid) * 8;
    f32x4 a = *(const f32x4*)(src + i), b = *(const f32x4*)(src + i + 4);
    u32x4 o = {pk2(a[0], a[1]), pk2(a[2], a[3]), pk2(b[0], b[1]), pk2(b[2], b[3])};
    *(u32x4*)(dst + i) = o;
  }
}

DI void quant_rows_task(const float* __restrict__ src, unsigned char* __restrict__ dst, float* __restrict__ scl, int row0) {
  const int tid = tid_opaque(), lane = tid & 63, w = tid >> 6;
#pragma unroll 2
  for (int q = 0; q < 8; ++q) {
    const int row = row0 + w * 8 + q;
    const float* sp = src + (size_t)row * 1024 + lane * 16;
    f32x4 v[4];
    float am = 0.f;
#pragma unroll
    for (int i = 0; i < 4; ++i) { v[i] = *(const f32x4*)(sp + 4 * i); am = fmaxf(am, fmaxf(fmaxf(fabsf(v[i][0]), fabsf(v[i][1])), fmaxf(fabsf(v[i][2]), fabsf(v[i][3])))); }
    am = wave_max(am);
    const float sc = am > 0.f ? am * (1.f / 400.f) : 1.f;
    const float inv = 1.f / sc;
    u32x4 o;
#pragma unroll
    for (int i = 0; i < 4; ++i) {
      int wd = __builtin_amdgcn_cvt_pk_fp8_f32(v[i][0] * inv, v[i][1] * inv, 0, false);
      wd = __builtin_amdgcn_cvt_pk_fp8_f32(v[i][2] * inv, v[i][3] * inv, wd, true);
      o[i] = (unsigned)wd;
    }
    *(u32x4*)(dst + (size_t)row * 1024 + lane * 16) = o;
    if (lane == 0) scl[row] = sc;
  }
}

DI void quant_rows_fp4_task(const float* __restrict__ src, unsigned char* __restrict__ dst, float* __restrict__ scl, int row0) {
  const int tid = tid_opaque(), lane = tid & 63, w = tid >> 6;
#pragma unroll 2
  for (int q = 0; q < 8; ++q) {
    const int row = row0 + w * 8 + q;
    const float* sp = src + (size_t)row * 1024 + lane * 16;
    f32x4 v[4];
    float am = 0.f;
#pragma unroll
    for (int i = 0; i < 4; ++i) { v[i] = *(const f32x4*)(sp + 4 * i); am = fmaxf(am, fmaxf(fmaxf(fabsf(v[i][0]), fabsf(v[i][1])), fmaxf(fabsf(v[i][2]), fabsf(v[i][3])))); }
    am = wave_max(am);
    const float sc = am > 0.f ? am * (1.f / 6.f) : 1.f;
    const float inv = 1.f / sc;
    u32x2 o;
#pragma unroll
    for (int j = 0; j < 2; ++j) {
      unsigned wd = 0u;
      wd = __builtin_amdgcn_cvt_scalef32_pk_fp4_f32(wd, v[2 * j][0] * inv, v[2 * j][1] * inv, 1.0f, 0);
      wd = __builtin_amdgcn_cvt_scalef32_pk_fp4_f32(wd, v[2 * j][2] * inv, v[2 * j][3] * inv, 1.0f, 1);
      wd = __builtin_amdgcn_cvt_scalef32_pk_fp4_f32(wd, v[2 * j + 1][0] * inv, v[2 * j + 1][1] * inv, 1.0f, 2);
      wd = __builtin_amdgcn_cvt_scalef32_pk_fp4_f32(wd, v[2 * j + 1][2] * inv, v[2 * j + 1][3] * inv, 1.0f, 3);
      o[j] = wd;
    }
    *(u32x2*)(dst + (size_t)row * 512 + lane * 8) = o;
    if (lane == 0) scl[row] = sc;
  }
}

DI void prep_phase(const Params& p, char* smem) {
  const int tid = tid_opaque();
  constexpr int N_MOD = 768, N_TR_L = 1240, N_TR = 2 * N_TR_L;
  constexpr int B_TR = N_MOD, B_PK = B_TR + N_TR, B_GWS = B_PK + 16, B_PU = B_GWS + 32, B_PV = B_PU + 1024, B_ZP = B_PV + 1024, B_RT = B_ZP + 2, N_ALL = B_RT + 1;
  for (int task = blockIdx.x; task < N_ALL; task += gridDim.x) {
    if (task < B_TR) {
      const int l = task / 384, rem = task % 384, nc = rem >> 4, kc = rem & 15;
      float* sc = (float*)smem;
      __syncthreads();
      for (int e = tid; e < 576; e += 256) {
        int r = e >> 6, k = e & 63;
        float v = (r == 0) ? p.c_ctx[kc * 64 + k] : p.c[(r - 1) * 1024 + kc * 64 + k];
        sc[e] = v / (1.f + __expf(-v));
      }
      __syncthreads();
      const int n = nc * 256 + tid;
      const float* w = p.w_mod + ((size_t)l * 1024 + kc * 64) * 6144 + n;
      float acc[9];
#pragma unroll
      for (int r = 0; r < 9; ++r) acc[r] = 0.f;
#pragma unroll 8
      for (int k = 0; k < 64; ++k) {
        float wv = w[(size_t)k * 6144];
#pragma unroll
        for (int r = 0; r < 9; ++r) acc[r] += sc[r * 64 + k] * wv;
      }
      float* mod = (float*)(p.ws + OFF_MOD) + (size_t)l * 9 * 6144;
      float bias = (kc == 0) ? p.b_mod[l * 6144 + n] : 0.f;
#pragma unroll
      for (int r = 0; r < 9; ++r) unsafeAtomicAdd(&mod[r * 6144 + n], acc[r] + bias);
    } else if (task < B_PK) {
      int j = task - B_TR; const int l = j / N_TR_L; int r = j % N_TR_L;
      if (r < 432) { int kt = r / 27, nt = r % 27; transpose_tile(p.w_in + (size_t)l * 1024 * 1696, 1696, (u16*)(p.ws + OFF_WIN) + (size_t)l * 1792 * WP, WP, kt * 64, nt * 64, smem); }
      else if (r < 456) { r -= 432; int kt = r / 6, nt = r % 6; transpose_tile(p.w_uq + (size_t)l * 256 * 384, 384, (u16*)(p.ws + OFF_WUQ) + (size_t)l * 384 * 256, 256, kt * 64, nt * 64, smem); }
      else if (r < 472) { r -= 456; int kt = r / 8, nt = r % 8; transpose_tile(p.w_ukv + (size_t)l * 128 * 512, 512, (u16*)(p.ws + OFF_WUKV) + (size_t)l * 512 * 128, 128, kt * 64, nt * 64, smem); }
      else if (r < 728) { r -= 472; int kt = r / 16, nt = r % 16; transpose_tile(p.w_o + (size_t)l * 1024 * 1024, 1024, (u16*)(p.ws + OFF_WO) + (size_t)l * 1024 * WP, WP, kt * 64, nt * 64, smem); }
      else { r -= 728; int kt = r / 32, nt = r % 32; transpose_tile(p.pwq + (size_t)l * 1024 * 2048, 2048, (u16*)(p.ws + OFF_PWQ) + (size_t)l * 2048 * WP, WP, kt * 64, nt * 64, smem); }
    } else if (task < B_GWS) {
      int j = task - B_PK;
      int l = j >> 3, half = (j >> 2) & 1, ch = j & 3;
      const float* src = (half ? p.pk2 : p.pk1) + (size_t)l * 16384;
      convert_task(src, (u16*)(p.ws + OFF_PK) + (size_t)(l * 2 + half) * 16384, (size_t)ch * 4096);
    } else if (task < B_PU) {
      convert_task(p.gws, (u16*)(p.ws + OFF_GWS), (size_t)(task - B_GWS) * 4096);
    } else if (task < B_PV) {
      quant_rows_fp4_task(p.pu, (unsigned char*)(p.ws + OFF_PU), (float*)(p.ws + OFF_SU), (task - B_PU) * 32);
    } else if (task < B_ZP) {
      quant_rows_fp4_task(p.pv, (unsigned char*)(p.ws + OFF_PV), (float*)(p.ws + OFF_SV), (task - B_PV) * 32);
    } else if (task < B_RT) {
      int l = task - B_ZP;
      u16* dst = (u16*)(p.ws + OFF_WIN) + ((size_t)l * 1792 + 1696) * WP;
      u32x4 z = {0u, 0u, 0u, 0u};
      for (int c = tid; c < 96 * WP / 8; c += 256) *(u32x4*)(dst + (size_t)c * 8) = z;
    } else {
      float* r16 = (float*)(p.ws + OFF_R16); float* r8 = (float*)(p.ws + OFF_R8);
      for (int e = tid; e < 1024; e += 256) {
        int pos = e >> 4, f = e & 15;
        float fr = exp2f(-(float)f * (13.287712379549449f / 16.f));
        float ang = (float)pos * fr;
        r16[e * 2] = __cosf(ang); r16[e * 2 + 1] = __sinf(ang);
      }
      for (int e = tid; e < 512; e += 256) {
        int pos = e >> 3, f = e & 7;
        float fr = exp2f(-(float)f * (13.287712379549449f / 8.f));
        float ang = (float)pos * fr;
        r8[e * 2] = __cosf(ang); r8[e * 2 + 1] = __sinf(ang);
      }
    }
  }
}


DI void s0_phase(const Params& p) {
  const int lane = tid_opaque() & 63, w = tid_opaque() >> 6;
  u16* H = (u16*)(p.ws + OFF_H);
  for (int t = blockIdx.x * 4 + w; t < T; t += gridDim.x * 4) {
    const float* xr = xin_row(p, t);
    float x[16];
#pragma unroll
    for (int i = 0; i < 4; ++i) { f32x4 v = *(const f32x4*)(xr + 4 * (lane + 64 * i)); x[4 * i] = v[0]; x[4 * i + 1] = v[1]; x[4 * i + 2] = v[2]; x[4 * i + 3] = v[3]; }
    float mu, rstd; ln_stats16(x, mu, rstd);
    const float* m = (const float*)(p.ws + OFF_MOD) + (size_t)tok_modrow(t) * 6144;
#pragma unroll
    for (int i = 0; i < 4; ++i) {
      int c = 4 * (lane + 64 * i);
      f32x4 sh = *(const f32x4*)(m + c), sc = *(const f32x4*)(m + 1024 + c);
      float h0 = (x[4 * i] - mu) * rstd * (1.f + sc[0]) + sh[0];
      float h1 = (x[4 * i + 1] - mu) * rstd * (1.f + sc[1]) + sh[1];
      float h2 = (x[4 * i + 2] - mu) * rstd * (1.f + sc[2]) + sh[2];
      float h3 = (x[4 * i + 3] - mu) * rstd * (1.f + sc[3]) + sh[3];
      u32x2 o = {pk2(h0, h1), pk2(h2, h3)};
      *(u32x2*)(H + (size_t)t * HP + c) = o;
    }
  }
}

DI void gemm_mainloop(const u16* __restrict__ A, int lda, const u16* __restrict__ B, int ldb, int K, char* smem, f32x16 (&acc)[2][2], int nact = 4) {
  const int tid = tid_opaque(), lane = tid & 63, w = tid >> 6, wm = w >> 1, wn = w & 1, r = lane & 31, g = lane >> 5;
  char* As = smem; char* Bs = smem + 128 * 144;
#pragma unroll
  for (int mi = 0; mi < 2; ++mi)
#pragma unroll
    for (int ni = 0; ni < 2; ++ni)
#pragma unroll
      for (int i = 0; i < 16; ++i) acc[mi][ni][i] = 0.f;
  u32x4 ra[4], rb[4];
  const int lrow = tid >> 3, lkc = tid & 7;
  const u16* ga = A + (size_t)lrow * lda + lkc * 8;
  const u16* gb = B + (size_t)lrow * ldb + lkc * 8;
#pragma unroll
  for (int i = 0; i < 4; ++i) { ra[i] = *(const u32x4*)(ga + (size_t)(32 * i) * lda); rb[i] = *(const u32x4*)(gb + (size_t)(32 * i) * ldb); }
  for (int k0 = 0; k0 < K; k0 += 64) {
    __syncthreads();
#pragma unroll
    for (int i = 0; i < 4; ++i) {
      *(u32x4*)(As + (lrow + 32 * i) * 144 + lkc * 16) = ra[i];
      *(u32x4*)(Bs + (lrow + 32 * i) * 144 + lkc * 16) = rb[i];
    }
    __syncthreads();
    if (k0 + 64 < K) {
#pragma unroll
      for (int i = 0; i < 4; ++i) { ra[i] = *(const u32x4*)(ga + (size_t)(32 * i) * lda + k0 + 64); rb[i] = *(const u32x4*)(gb + (size_t)(32 * i) * ldb + k0 + 64); }
    }
    __builtin_amdgcn_s_setprio(2);
    if (2 * wm + 1 < nact) {
#pragma unroll
      for (int ks = 0; ks < 4; ++ks) {
        bf16x8 af[2], bfr[2];
#pragma unroll
        for (int mi = 0; mi < 2; ++mi) af[mi] = *(const bf16x8*)(As + (64 * wm + 32 * mi + r) * 144 + (16 * ks + 8 * g) * 2);
#pragma unroll
        for (int ni = 0; ni < 2; ++ni) bfr[ni] = *(const bf16x8*)(Bs + (64 * wn + 32 * ni + r) * 144 + (16 * ks + 8 * g) * 2);
#pragma unroll
        for (int mi = 0; mi < 2; ++mi)
#pragma unroll
          for (int ni = 0; ni < 2; ++ni) acc[mi][ni] = MFMA32(af[mi], bfr[ni], acc[mi][ni]);
      }
    } else if (2 * wm < nact) {
#pragma unroll
      for (int ks = 0; ks < 4; ++ks) {
        const bf16x8 af0 = *(const bf16x8*)(As + (64 * wm + r) * 144 + (16 * ks + 8 * g) * 2);
#pragma unroll
        for (int ni = 0; ni < 2; ++ni) {
          const bf16x8 bf0 = *(const bf16x8*)(Bs + (64 * wn + 32 * ni + r) * 144 + (16 * ks + 8 * g) * 2);
          acc[0][ni] = MFMA32(af0, bf0, acc[0][ni]);
        }
      }
    }
    __builtin_amdgcn_s_setprio(0);
  }
}

DI void epi_store_f32(const f32x16 (&acc)[2][2], float* __restrict__ C, int ldc, int n0, int t0) {
  const int lane = tid_opaque() & 63, w = tid_opaque() >> 6, wm = w >> 1, wn = w & 1, r = lane & 31, g = lane >> 5;
#pragma unroll
  for (int mi = 0; mi < 2; ++mi)
#pragma unroll
    for (int ni = 0; ni < 2; ++ni) {
      const int t = t0 + 64 * wn + 32 * ni + r;
#pragma unroll
      for (int i = 0; i < 4; ++i) {
        const int n = n0 + 64 * wm + 32 * mi + 8 * i + 4 * g;
        f32x4 v = {acc[mi][ni][4 * i], acc[mi][ni][4 * i + 1], acc[mi][ni][4 * i + 2], acc[mi][ni][4 * i + 3]};
        *(f32x4*)(C + (size_t)t * ldc + n) = v;
      }
    }
}

DI void g1_phase(const Params& p, int l, char* smem) {
  const u16* W = (const u16*)(p.ws + OFF_WIN) + (size_t)l * 1792 * WP;
  const u16* H = (const u16*)(p.ws + OFF_H);
  float* PROJ = (float*)(p.ws + OFF_PROJ);
  const int xq = blockIdx.x & 7, qq = blockIdx.x >> 3, nbx = (int)((gridDim.x - xq + 7) >> 3);
  for (int i = qq; i < 24 * 14; i += nbx) {
    const int tt = (i / 14) * 8 + xq, nt = i % 14;
    f32x16 acc[2][2];
    gemm_mainloop(W + (size_t)nt * 128 * WP, WP, H + (size_t)tt * 128 * HP, HP, 1024, smem, acc, nt == 13 ? 1 : 4);
    epi_store_f32(acc, PROJ, PLD, nt * 128, tt * 128);
  }
}

DI void rope16_apply(float (&v)[8], int c, int rowp, int colp, const float* __restrict__ r16) {
  const int pos = (c < 4) ? rowp : colp;
  const float* tb = r16 + (size_t)(pos * 16 + (c & 1) * 8) * 2;
  const bool is_x1 = (c & 2) == 0;
#pragma unroll
  for (int e = 0; e < 8; ++e) {
    float pv = __shfl_xor(v[e], 2);
    float cs = tb[2 * e], sn = tb[2 * e + 1];
    v[e] = is_x1 ? (v[e] * cs - pv * sn) : (pv * sn + v[e] * cs);
  }
}

DI void r1_phase(const Params& p, int l, char* smem) {
  const int tid = tid_opaque(), lane = tid & 63, w = tid >> 6;
  u16* sT = (u16*)smem;
  const float* PROJ = (const float*)(p.ws + OFF_PROJ);
  const float* r16 = (const float*)(p.ws + OFF_R16);
  const float* r8 = (const float*)(p.ws + OFF_R8);
  u16* QA = (u16*)(p.ws + OFF_QA); u16* CQ = (u16*)(p.ws + OFF_CQ); u16* UC = (u16*)(p.ws + OFF_UC); u16* VGT = (u16*)(p.ws + OFF_VGT);
  u16* KA = (u16*)(p.ws + OFF_KA); u16* VAT = (u16*)(p.ws + OFF_VAT); u16* CKV = (u16*)(p.ws + OFF_CKV); u16* KM = (u16*)(p.ws + OFF_KM);
  const float* aqn = p.aqn + l * 64; const float* akn = p.akn + l * 64; const float* mqn = p.mqn + l * 256; const float* mkvn = p.mkvn + l * 128;
  constexpr int NTB = T / 32;
  for (int task0 = blockIdx.x; task0 < NTB + 64; task0 += gridDim.x) {
    const int task = (task0 < 64) ? (NTB + task0) : (task0 - 64);
    __syncthreads();
    if (task < NTB) {
      const int t0 = task * 32;
      for (int q = 0; q < 8; ++q) {
        const int tl = w * 8 + q, t = t0 + tl;
        const float* pr = PROJ + (size_t)t * PLD;
        const bool lat = t >= TC;
        const int s = lat ? ((t - TC) & 2047) : (t & 255);
        const int bctx = t >> 8;
        const int rowp = s >> 6, colp = s & 63;
        const int kr = tok_keyrow(t);
        const int c = lane & 7;
        {
          f32x4 a = *(const f32x4*)(pr + lane * 8), b = *(const f32x4*)(pr + lane * 8 + 4);
          float v[8] = {a[0], a[1], a[2], a[3], b[0], b[1], b[2], b[3]};
          float ss = 0.f;
#pragma unroll
          for (int e = 0; e < 8; ++e) ss += v[e] * v[e];
          ss += __shfl_xor(ss, 1); ss += __shfl_xor(ss, 2); ss += __shfl_xor(ss, 4);
          float rinv = rsqrtf(ss * (1.f / 64.f) + EPS);
#pragma unroll
          for (int e = 0; e < 8; ++e) v[e] = v[e] * rinv * aqn[c * 8 + e];
          if (lat) rope16_apply(v, c, rowp, colp, r16);
          const float sc = 0.125f * LOG2E;
          u32x4 o = {pk2(v[0] * sc, v[1] * sc), pk2(v[2] * sc, v[3] * sc), pk2(v[4] * sc, v[5] * sc), pk2(v[6] * sc, v[7] * sc)};
          *(u32x4*)(QA + (size_t)t * 512 + lane * 8) = o;
        }
        {
          const int ln = lane & 31;
          f32x4 a = *(const f32x4*)(pr + 512 + ln * 8), b = *(const f32x4*)(pr + 512 + ln * 8 + 4);
          float v[8] = {a[0], a[1], a[2], a[3], b[0], b[1], b[2], b[3]};
          float ss = 0.f;
#pragma unroll
          for (int e = 0; e < 8; ++e) ss += v[e] * v[e];
          ss += __shfl_xor(ss, 1); ss += __shfl_xor(ss, 2); ss += __shfl_xor(ss, 4);
          float rinv = rsqrtf(ss * (1.f / 64.f) + EPS);
          float kv[8];
#pragma unroll
          for (int e = 0; e < 8; ++e) kv[e] = v[e] * rinv * akn[c * 8 + e];
          if (!lat && lane < 16) {
            float* o = p.out + OUT_K + ((size_t)((bctx * 2 + l) * 256 + s)) * 128 + lane * 8;
            f32x4 o0 = {kv[0], kv[1], kv[2], kv[3]}, o1 = {kv[4], kv[5], kv[6], kv[7]};
            *(f32x4*)o = o0; *(f32x4*)(o + 4) = o1;
          }
          if (lat) rope16_apply(kv, c, rowp, colp, r16);
          if (lane < 16) {
            u32x4 o = {pk2(kv[0], kv[1]), pk2(kv[2], kv[3]), pk2(kv[4], kv[5]), pk2(kv[6], kv[7])};
            *(u32x4*)(KA + (size_t)kr * 128 + lane * 8) = o;
          } else if (lane < 32) {
            const int ch = (lane - 16) * 8;
            if (!lat) {
              float* o = p.out + OUT_V + ((size_t)((bctx * 2 + l) * 256 + s)) * 128 + ch;
              *(f32x4*)o = a; *(f32x4*)(o + 4) = b;
            }
#pragma unroll
            for (int e = 0; e < 8; ++e) sT[(ch + e) * 40 + tl] = (u16)(pk2(v[e], 0.f) & 0xffffu);
          }
        }
        {
          f32x4 a = *(const f32x4*)(pr + 768 + lane * 4);
          float ss = a[0] * a[0] + a[1] * a[1] + a[2] * a[2] + a[3] * a[3];
          ss = wave_sum(ss);
          float rinv = rsqrtf(ss * (1.f / 256.f) + EPS);
          f32x4 gq = *(const f32x4*)(mqn + lane * 4);
          u32x2 o = {pk2(a[0] * rinv * gq[0], a[1] * rinv * gq[1]), pk2(a[2] * rinv * gq[2], a[3] * rinv * gq[3])};
          *(u32x2*)(CQ + (size_t)t * 256 + lane * 4) = o;
        }
        {
          f32x2_t a = *(const f32x2_t*)(pr + 1024 + lane * 2);
          float ss = wave_sum(a[0] * a[0] + a[1] * a[1]);
          float rinv = rsqrtf(ss * (1.f / 128.f) + EPS);
          float c0 = a[0] * rinv * mkvn[lane * 2], c1 = a[1] * rinv * mkvn[lane * 2 + 1];
          if (!lat) { f32x2_t o = {c0, c1}; *(f32x2_t*)(p.out + OUT_CKV + ((size_t)((bctx * 2 + l) * 256 + s)) * 128 + lane * 2) = o; }
          *(unsigned*)(CKV + (size_t)kr * 128 + lane * 2) = pk2(c0, c1);
        }
        {
          const int ln = lane & 31;
          float v = pr[1152 + ln];
          if (!lat && lane < 32) p.out[OUT_KR + ((size_t)((bctx * 2 + l) * 256 + s)) * 32 + ln] = v;
          if (lat) {
            float pv = __shfl_xor(v, 8);
            const int pos = (ln >> 4) ? colp : rowp;
            const float* tb = r8 + (size_t)(pos * 8 + (ln & 7)) * 2;
            float cs = tb[0], sn = tb[1];
            v = (ln & 8) ? (pv * sn + v * cs) : (v * cs - pv * sn);
          }
          if (lane < 32) {
            u16 hv = (u16)(pk2(v, 0.f) & 0xffffu);
#pragma unroll
            for (int h = 0; h < 4; ++h) KM[(size_t)kr * 384 + h * 96 + 64 + ln] = hv;
          }
        }
        {
          f32x4 a = *(const f32x4*)(pr + 1184 + lane * 4);
          u32x2 o = {pk2(a[0], a[1]), pk2(a[2], a[3])};
          *(u32x2*)(UC + (size_t)t * 256 + lane * 4) = o;
        }
        {
          f32x4 a = *(const f32x4*)(pr + 1440 + lane * 4);
          float sm = a[0] + a[1] + a[2] + a[3];
          sm += __shfl_xor(sm, 1); sm += __shfl_xor(sm, 2); sm += __shfl_xor(sm, 4); sm += __shfl_xor(sm, 8);
          float mu = sm * (1.f / 64.f);
          float d0 = a[0] - mu, d1 = a[1] - mu, d2 = a[2] - mu, d3 = a[3] - mu;
          float q2 = d0 * d0 + d1 * d1 + d2 * d2 + d3 * d3;
          q2 += __shfl_xor(q2, 1); q2 += __shfl_xor(q2, 2); q2 += __shfl_xor(q2, 4); q2 += __shfl_xor(q2, 8);
          float rstd = rsqrtf(q2 * (1.f / 64.f) + EPS);
          unsigned u0 = pk2(d0 * rstd, d1 * rstd), u1 = pk2(d2 * rstd, d3 * rstd);
          const int ch = 128 + lane * 4;
          sT[(ch + 0) * 40 + tl] = (u16)(u0 & 0xffffu); sT[(ch + 1) * 40 + tl] = (u16)(u0 >> 16);
          sT[(ch + 2) * 40 + tl] = (u16)(u1 & 0xffffu); sT[(ch + 3) * 40 + tl] = (u16)(u1 >> 16);
        }
      }
      __syncthreads();
      const int kr0 = tok_keyrow(t0);
      const int chunk = t0 >> 7, q0 = t0 & 127;
#pragma unroll
      for (int it = 0; it < 6; ++it) {
        int id = tid + 256 * it, row = id >> 2, cc = id & 3;
        u32x4 v = *(const u32x4*)(sT + row * 40 + cc * 8);
        if (row < 128) *(u32x4*)(VAT + vt_index(kr0, row, 128) + cc * 8) = v;
        else { int gd = row - 128; *(u32x4*)(VGT + ((size_t)(chunk * 256 + gd)) * 128 + q0 + cc * 8) = v; }
      }
    } else {
      const int j = task - NTB, bl = j >> 3, p0 = (j & 7) * 32;
      for (int q = 0; q < 8; ++q) {
        const int tl = w * 8 + q, pp = p0 + tl;
        const size_t crow = (size_t)((bl * 2 + l) * 256 + pp);
        const int kr = TC + bl * 2304 + pp;
        f32x2_t k2 = *(const f32x2_t*)(p.cache_k + crow * 128 + lane * 2);
        *(unsigned*)(KA + (size_t)kr * 128 + lane * 2) = pk2(k2[0], k2[1]);
        f32x2_t v2 = *(const f32x2_t*)(p.cache_v + crow * 128 + lane * 2);
        unsigned uv = pk2(v2[0], v2[1]);
        sT[(lane * 2) * 40 + tl] = (u16)(uv & 0xffffu); sT[(lane * 2 + 1) * 40 + tl] = (u16)(uv >> 16);
        f32x2_t c2 = *(const f32x2_t*)(p.cache_ckv + crow * 128 + lane * 2);
        *(unsigned*)(CKV + (size_t)kr * 128 + lane * 2) = pk2(c2[0], c2[1]);
        if (lane < 32) {
          float v = p.cache_kr[crow * 32 + lane];
          u16 hv = (u16)(pk2(v, 0.f) & 0xffffu);
#pragma unroll
          for (int h = 0; h < 4; ++h) KM[(size_t)kr * 384 + h * 96 + 64 + lane] = hv;
        }
      }
      __syncthreads();
      const int kr0 = TC + bl * 2304 + p0;
#pragma unroll
      for (int it = 0; it < 2; ++it) {
        int id = tid + 256 * it, row = id >> 2, cc = id & 3;
        u32x4 v = *(const u32x4*)(sT + row * 40 + cc * 8);
        *(u32x4*)(VAT + vt_index(kr0, row, 128) + cc * 8) = v;
      }
    }
  }
}

DI void mid_phase(const Params& p, int l, char* smem) {
  const int tid = tid_opaque(), lane = tid & 63, w = tid >> 6, wm = w >> 1, wn = w & 1, r = lane & 31, g = lane >> 5;
  constexpr int N_G2 = 192 * 3, N_G3 = 208 * 4, N_C1 = 192 * 4;
  for (int task = blockIdx.x; task < N_G2 + N_G3 + N_C1; task += gridDim.x) {
    if (task < N_G2) {
      const int tt = task / 3, nt = task % 3;
      const u16* W = (const u16*)(p.ws + OFF_WUQ) + (size_t)l * 384 * 256;
      const u16* CQ = (const u16*)(p.ws + OFF_CQ);
      u16* QM = (u16*)(p.ws + OFF_QM);
      const float* r8 = (const float*)(p.ws + OFF_R8);
      f32x16 acc[2][2];
      gemm_mainloop(W + (size_t)nt * 128 * 256, 256, CQ + (size_t)tt * 128 * 256, 256, 256, smem, acc);
      const float sc = LOG2E * 0.10206207261596577f;
#pragma unroll
      for (int mi = 0; mi < 2; ++mi) {
        const int nb = nt * 128 + 64 * wm + 32 * mi;
        const bool is_rope = (nb % 96) == 64;
#pragma unroll
        for (int ni = 0; ni < 2; ++ni) {
          const int t = tt * 128 + 64 * wn + 32 * ni + r;
          float v[16];
#pragma unroll
          for (int i = 0; i < 16; ++i) v[i] = acc[mi][ni][i];
          if (is_rope && t >= TC) {
            const int s = (t - TC) & 2047, rowp = s >> 6, colp = s & 63;
#pragma unroll
            for (int j = 0; j < 4; ++j) {
              const float* tb = r8 + (size_t)(rowp * 8 + 4 * g + j) * 2;
              float cs = tb[0], sn = tb[1];
              float x1 = v[j], x2 = v[4 + j];
              v[j] = x1 * cs - x2 * sn; v[4 + j] = x1 * sn + x2 * cs;
              const float* tc = r8 + (size_t)(colp * 8 + 4 * g + j) * 2;
              cs = tc[0]; sn = tc[1];
              x1 = v[8 + j]; x2 = v[12 + j];
              v[8 + j] = x1 * cs - x2 * sn; v[12 + j] = x1 * sn + x2 * cs;
            }
          }
#pragma unroll
          for (int i = 0; i < 4; ++i) {
            u32x2 o = {pk2(v[4 * i] * sc, v[4 * i + 1] * sc), pk2(v[4 * i + 2] * sc, v[4 * i + 3] * sc)};
            *(u32x2*)(QM + (size_t)t * 384 + nb + 8 * i + 4 * g) = o;
          }
        }
      }
    } else if (task < N_G2 + N_G3) {
      const int j = task - N_G2, tt = j >> 2, h = j & 3;
      const u16* W = (const u16*)(p.ws + OFF_WUKV) + (size_t)l * 512 * 128;
      const u16* CKV = (const u16*)(p.ws + OFF_CKV);
      u16* KM = (u16*)(p.ws + OFF_KM); u16* VMT = (u16*)(p.ws + OFF_VMT);
      f32x16 acc[2][2];
      gemm_mainloop(W + (size_t)h * 128 * 128, 128, CKV + (size_t)tt * 128 * 128, 128, 128, smem, acc);
#pragma unroll
      for (int mi = 0; mi < 2; ++mi)
#pragma unroll
        for (int ni = 0; ni < 2; ++ni) {
          const int kr = tt * 128 + 64 * wn + 32 * ni + r;
          if (wm == 0) {
#pragma unroll
            for (int i = 0; i < 4; ++i) {
              u32x2 o = {pk2(acc[mi][ni][4 * i], acc[mi][ni][4 * i + 1]), pk2(acc[mi][ni][4 * i + 2], acc[mi][ni][4 * i + 3])};
              *(u32x2*)(KM + (size_t)kr * 384 + h * 96 + 32 * mi + 8 * i + 4 * g) = o;
            }
          } else {
            size_t vbase; int lseq;
            if (kr < TC) { vbase = (size_t)(kr >> 8) * 256 * 256 + (kr & 255); lseq = 256; }
            else { const int u = kr - TC, bl = u / 2304, pos = u - bl * 2304; vbase = (size_t)32 * 256 * 256 + (size_t)bl * 256 * 2304 + pos; lseq = 2304; }
            u16* vp = VMT + vbase + (size_t)(h * 64 + 32 * mi + 4 * g) * lseq;
#pragma unroll
            for (int i = 0; i < 16; ++i)
              vp[(size_t)(8 * (i >> 2) + (i & 3)) * lseq] = (u16)(pk2(acc[mi][ni][i], 0.f) & 0xffffu);
          }
        }
    } else {
      const int j = task - N_G2 - N_G3, chunk = j >> 2, gg = j & 3;
      const u16* WS = (const u16*)(p.ws + OFF_GWS) + (size_t)(l * 4 + gg) * 128 * 128;
      const u16* VGT = (const u16*)(p.ws + OFF_VGT) + (size_t)(chunk * 4 + gg) * 64 * 128;
      const u16* UC = (const u16*)(p.ws + OFF_UC);
      u16* MIXIN = (u16*)(p.ws + OFF_MIXIN);
      f32x16 acc[2];
#pragma unroll
      for (int i = 0; i < 16; ++i) { acc[0][i] = 0.f; acc[1][i] = 0.f; }
      const int pp = 32 * w + r;
#pragma unroll
      for (int ks = 0; ks < 8; ++ks) {
        bf16x8 b = *(const bf16x8*)(WS + (size_t)pp * 128 + ks * 16 + 8 * g);
#pragma unroll
        for (int mt = 0; mt < 2; ++mt) {
          bf16x8 a = *(const bf16x8*)(VGT + (size_t)(32 * mt + r) * 128 + ks * 16 + 8 * g);
          acc[mt] = MFMA32(a, b, acc[mt]);
        }
      }
      const float bs = p.gb[(size_t)(l * 4 + gg) * 128 + pp];
      const int t = chunk * 128 + pp;
#pragma unroll
      for (int mt = 0; mt < 2; ++mt)
#pragma unroll
        for (int i = 0; i < 4; ++i) {
          const int d = 32 * mt + 8 * i + 4 * g;
          u32x2 u = *(const u32x2*)(UC + (size_t)t * 256 + gg * 64 + d);
          float o0 = bflo(u[0]) * (acc[mt][4 * i] + bs), o1 = bfhi(u[0]) * (acc[mt][4 * i + 1] + bs);
          float o2 = bflo(u[1]) * (acc[mt][4 * i + 2] + bs), o3 = bfhi(u[1]) * (acc[mt][4 * i + 3] + bs);
          u32x2 o = {pk2(o0, o1), pk2(o2, o3)};
          *(u32x2*)(MIXIN + (size_t)t * HP + 768 + gg * 64 + d) = o;
        }
    }
  }
}

template <int DK>
DI void attn_item(const u16* __restrict__ Q, int ldq, const u16* __restrict__ Kp, int ldk, const u16* __restrict__ VT, int L,
                  u16* __restrict__ O, char* smem) {
  constexpr int KS = DK / 16, KROW = (DK + 8) * 2, KCH = DK / 8, NKC = 64 * KCH / 256;
  const int tid = tid_opaque(), lane = tid & 63, w = tid >> 6, r = lane & 31, g = lane >> 5;
  char* Ks = smem; char* Vs = smem + 64 * KROW;
  bf16x8 qf[KS];
  {
    const u16* qrow = Q + (size_t)(32 * w + r) * ldq + 8 * g;
#pragma unroll
    for (int ks = 0; ks < KS; ++ks) qf[ks] = *(const bf16x8*)(qrow + 16 * ks);
  }
  f32x16 o[2];
#pragma unroll
  for (int i = 0; i < 16; ++i) { o[0][i] = 0.f; o[1][i] = 0.f; }
  float m = -1e30f, lsum = 0.f;
  u32x4 kreg[NKC], vreg[2];
#pragma unroll
  for (int i = 0; i < NKC; ++i) { int id = tid + 256 * i, row = id / KCH, c = id % KCH; kreg[i] = *(const u32x4*)(Kp + (size_t)row * ldk + c * 8); }
#pragma unroll
  for (int i = 0; i < 2; ++i) { int id = tid + 256 * i, row = id >> 3, c = id & 7; vreg[i] = *(const u32x4*)(VT + (size_t)row * L + c * 8); }
  for (int key0 = 0; key0 < L; key0 += 64) {
    __syncthreads();
#pragma unroll
    for (int i = 0; i < NKC; ++i) { int id = tid + 256 * i, row = id / KCH, c = id % KCH; *(u32x4*)(Ks + row * KROW + c * 16) = kreg[i]; }
#pragma unroll
    for (int i = 0; i < 2; ++i) { int id = tid + 256 * i, row = id >> 3, c = id & 7; *(u32x4*)(Vs + row * 144 + c * 16) = vreg[i]; }
    __syncthreads();
    if (key0 + 64 < L) {
      const int kn = key0 + 64;
#pragma unroll
      for (int i = 0; i < NKC; ++i) { int id = tid + 256 * i, row = id / KCH, c = id % KCH; kreg[i] = *(const u32x4*)(Kp + (size_t)(kn + row) * ldk + c * 8); }
#pragma unroll
      for (int i = 0; i < 2; ++i) { int id = tid + 256 * i, row = id >> 3, c = id & 7; vreg[i] = *(const u32x4*)(VT + (size_t)row * L + kn + c * 8); }
    }
    __builtin_amdgcn_s_setprio(2);
    f32x16 s[2];
#pragma unroll
    for (int i = 0; i < 16; ++i) { s[0][i] = 0.f; s[1][i] = 0.f; }
#pragma unroll
    for (int ks = 0; ks < KS; ++ks)
#pragma unroll
      for (int mt = 0; mt < 2; ++mt) {
        bf16x8 a = *(const bf16x8*)(Ks + (32 * mt + r) * KROW + (16 * ks + 8 * g) * 2);
        s[mt] = MFMA32(a, qf[ks], s[mt]);
      }
    float mx = s[0][0];
#pragma unroll
    for (int i = 0; i < 16; ++i) { mx = fmaxf(mx, s[0][i]); mx = fmaxf(mx, s[1][i]); }
    mx = fmaxf(mx, __shfl_xor(mx, 32));
    const float mnew = fmaxf(m, mx);
    const float alpha = __builtin_amdgcn_exp2f(m - mnew);
    m = mnew;
    float ps = 0.f;
#pragma unroll
    for (int mt = 0; mt < 2; ++mt)
#pragma unroll
      for (int i = 0; i < 16; ++i) { float e = __builtin_amdgcn_exp2f(s[mt][i] - mnew); s[mt][i] = e; ps += e; }
    lsum = lsum * alpha + ps;
#pragma unroll
    for (int i = 0; i < 16; ++i) { o[0][i] *= alpha; o[1][i] *= alpha; }
#pragma unroll
    for (int mt = 0; mt < 2; ++mt)
#pragma unroll
      for (int ip = 0; ip < 2; ++ip) {
        u32x4 pb = {pk2(s[mt][8 * ip], s[mt][8 * ip + 1]), pk2(s[mt][8 * ip + 2], s[mt][8 * ip + 3]),
                    pk2(s[mt][8 * ip + 4], s[mt][8 * ip + 5]), pk2(s[mt][8 * ip + 6], s[mt][8 * ip + 7])};
        bf16x8 pbv = __builtin_bit_cast(bf16x8, pb);
#pragma unroll
        for (int dt = 0; dt < 2; ++dt) {
          const char* vrow = Vs + (32 * dt + r) * 144 + (32 * mt + 16 * ip + 4 * g) * 2;
          u32x2 lo = *(const u32x2*)(vrow), hi = *(const u32x2*)(vrow + 16);
          u32x4 av = {lo[0], lo[1], hi[0], hi[1]};
          o[dt] = MFMA32(__builtin_bit_cast(bf16x8, av), pbv, o[dt]);
        }
      }
    __builtin_amdgcn_s_setprio(0);
  }
  lsum += __shfl_xor(lsum, 32);
  const float inv = 1.f / lsum;
  u16* orow = O + (size_t)(32 * w + r) * HP;
#pragma unroll
  for (int dt = 0; dt < 2; ++dt)
#pragma unroll
    for (int i = 0; i < 4; ++i) {
      u32x2 ov = {pk2(o[dt][4 * i] * inv, o[dt][4 * i + 1] * inv), pk2(o[dt][4 * i + 2] * inv, o[dt][4 * i + 3] * inv)};
      *(u32x2*)(orow + 32 * dt + 8 * i + 4 * g) = ov;
    }
}

DI void attn_phase(const Params& p, char* smem) {
  const u16* QA = (const u16*)(p.ws + OFF_QA); const u16* QM = (const u16*)(p.ws + OFF_QM);
  const u16* KA = (const u16*)(p.ws + OFF_KA); const u16* KM = (const u16*)(p.ws + OFF_KM);
  const u16* VAT = (const u16*)(p.ws + OFF_VAT); const u16* VMT = (const u16*)(p.ws + OFF_VMT);
  u16* MIXIN = (u16*)(p.ws + OFF_MIXIN);
  const int xq = blockIdx.x & 7, qq = blockIdx.x >> 3, nbx = (int)((gridDim.x - xq + 7) >> 3);
  for (int i = qq; i < 288; i += nbx) {
    if (i < 64) {
      const int bl = xq, h = i >> 4, qb = i & 15;
      const int t0 = TC + bl * 2048 + qb * 128, kr0 = TC + bl * 2304;
      attn_item<96>(QM + (size_t)t0 * 384 + h * 96, 384, KM + (size_t)kr0 * 384 + h * 96, 384,
                    VMT + (size_t)32 * 256 * 256 + (size_t)(bl * 256 + h * 64) * 2304, 2304, MIXIN + (size_t)t0 * HP + 512 + h * 64, smem);
    } else if (i < 192) {
      const int j = i - 64, bl = xq, hq = j >> 4, qb = j & 15, kvh = hq >> 2;
      const int t0 = TC + bl * 2048 + qb * 128, kr0 = TC + bl * 2304;
      attn_item<64>(QA + (size_t)t0 * 512 + hq * 64, 512, KA + (size_t)kr0 * 128 + kvh * 64, 128,
                    VAT + (size_t)32 * 128 * 256 + (size_t)(bl * 128 + kvh * 64) * 2304, 2304, MIXIN + (size_t)t0 * HP + hq * 64, smem);
    } else {
      const int j = i - 192, b = xq * 4 + j / 24, rem = j % 24;
      const int kr0 = b * 256;
      if (rem < 8) {
        const int h = rem >> 1, qb = rem & 1, t0 = b * 256 + qb * 128;
        attn_item<96>(QM + (size_t)t0 * 384 + h * 96, 384, KM + (size_t)kr0 * 384 + h * 96, 384,
                      VMT + (size_t)(b * 256 + h * 64) * 256, 256, MIXIN + (size_t)t0 * HP + 512 + h * 64, smem);
      } else {
        const int rr = rem - 8, hq = rr >> 1, qb = rr & 1, kvh = hq >> 2, t0 = b * 256 + qb * 128;
        attn_item<64>(QA + (size_t)t0 * 512 + hq * 64, 512, KA + (size_t)kr0 * 128 + kvh * 64, 128,
                      VAT + (size_t)(b * 128 + kvh * 64) * 256, 256, MIXIN + (size_t)t0 * HP + hq * 64, smem);
      }
    }
  }
}

DI void g4_phase(const Params& p, int l, char* smem) {
  const u16* W = (const u16*)(p.ws + OFF_WO) + (size_t)l * 1024 * WP;
  const u16* X = (const u16*)(p.ws + OFF_MIXIN);
  float* C = (float*)(p.ws + OFF_MIXOUT);
  const int xq = blockIdx.x & 7, qq = blockIdx.x >> 3, nbx = (int)((gridDim.x - xq + 7) >> 3);
  for (int i = qq; i < 24 * 8; i += nbx) {
    const int tt = (i >> 3) * 8 + xq, nt = i & 7;
    f32x16 acc[2][2];
    gemm_mainloop(W + (size_t)nt * 128 * WP, WP, X + (size_t)tt * 128 * HP, HP, 1024, smem, acc);
    epi_store_f32(acc, C, MP, nt * 128, tt * 128);
  }
}

DI void r2_phase(const Params& p, int l) {
  const int lane = tid_opaque() & 63, w = tid_opaque() >> 6;
  float* MIX = (float*)(p.ws + OFF_MIXOUT);
  u16* H2 = (u16*)(p.ws + OFF_H2);
  const float* lg = p.ln1g + l * 1024; const float* lb = p.ln1b + l * 1024;
  for (int t = blockIdx.x * 4 + w; t < T; t += gridDim.x * 4) {
    const float* xr = (l == 0) ? xin_row(p, t) : (p.out + (size_t)t * 1024);
    const float* m = (const float*)(p.ws + OFF_MOD) + (size_t)(l * 9 + tok_modrow(t)) * 6144;
    float y[16];
#pragma unroll
    for (int i = 0; i < 4; ++i) {
      int c = 4 * (lane + 64 * i);
      f32x4 xv = *(const f32x4*)(xr + c), mv = *(const f32x4*)(MIX + (size_t)t * MP + c), g1 = *(const f32x4*)(m + 2048 + c);
#pragma unroll
      for (int e = 0; e < 4; ++e) y[4 * i + e] = ALPHA * xv[e] + g1[e] * mv[e];
    }
    float mu, rstd; ln_stats16(y, mu, rstd);
#pragma unroll
    for (int i = 0; i < 4; ++i) {
      int c = 4 * (lane + 64 * i);
      f32x4 gv = *(const f32x4*)(lg + c), bv = *(const f32x4*)(lb + c);
      f32x4 o;
#pragma unroll
      for (int e = 0; e < 4; ++e) { y[4 * i + e] = (y[4 * i + e] - mu) * rstd * gv[e] + bv[e]; o[e] = y[4 * i + e]; }
      *(f32x4*)(MIX + (size_t)t * MP + c) = o;
    }
    ln_stats16(y, mu, rstd);
#pragma unroll
    for (int i = 0; i < 4; ++i) {
      int c = 4 * (lane + 64 * i);
      f32x4 sh = *(const f32x4*)(m + 3072 + c), sc = *(const f32x4*)(m + 4096 + c);
      float h[4];
#pragma unroll
      for (int e = 0; e < 4; ++e) h[e] = (y[4 * i + e] - mu) * rstd * (1.f + sc[e]) + sh[e];
      u32x2 o = {pk2(h[0], h[1]), pk2(h[2], h[3])};
      *(u32x2*)(H2 + (size_t)t * HP + c) = o;
    }
  }
}

DI void ce_desc(unsigned& a, unsigned& b) { unsigned mx = a > b ? a : b, mn = a > b ? b : a; a = mx; b = mn; }
DI void sort16_desc(unsigned (&a)[16]) {
#pragma unroll
  for (int k = 2; k <= 16; k <<= 1) {
#pragma unroll
    for (int j = k >> 1; j > 0; j >>= 1) {
#pragma unroll
      for (int i = 0; i < 16; ++i) {
        const int l2 = i ^ j;
        if (l2 > i) { if ((i & k) == 0) ce_desc(a[i], a[l2]); else ce_desc(a[l2], a[i]); }
      }
    }
  }
}
DI void merge16_desc(unsigned (&a)[16]) {
#pragma unroll
  for (int j = 8; j > 0; j >>= 1) {
#pragma unroll
    for (int i = 0; i < 16; ++i) { const int l2 = i ^ j; if (l2 > i) ce_desc(a[i], a[l2]); }
  }
}
DI void top16_merge(unsigned (&a)[16], const unsigned (&b)[16]) {
#pragma unroll
  for (int i = 0; i < 16; ++i) a[i] = a[i] > b[15 - i] ? a[i] : b[15 - i];
  merge16_desc(a);
}
DI unsigned score_key(float f, int idx) {
  unsigned u = __float_as_uint(f);
  u ^= (unsigned)((int)u >> 31) | 0x80000000u;
  return (u & ~127u) | (unsigned)(127 - idx);
}
DI float key_val(unsigned k) {
  unsigned u = k & ~127u;
  u = (u & 0x80000000u) ? (u ^ 0x80000000u) : ~u;
  return __uint_as_float(u);
}

DI void g5_phase(const Params& p, int l, char* smem) {
  const int tid = tid_opaque(), lane = tid & 63, w = tid >> 6, wm = w >> 1, wn = w & 1, r = lane & 31, g = lane >> 5;
  const u16* W = (const u16*)(p.ws + OFF_PWQ) + (size_t)l * 2048 * WP;
  const u16* X = (const u16*)(p.ws + OFF_H2);
  unsigned* TOPK = (unsigned*)(p.ws + OFF_TOPK);
  char* Qs = smem;
  const int xq = blockIdx.x & 7, qq = blockIdx.x >> 3, nbx = (int)((gridDim.x - xq + 7) >> 3);
  for (int i = qq; i < 24 * 16; i += nbx) {
    const int tt = (i >> 4) * 8 + xq, nt = i & 15;
    f32x16 acc[2][2];
    gemm_mainloop(W + (size_t)nt * 128 * WP, WP, X + (size_t)tt * 128 * HP, HP, 1024, smem, acc);
    __syncthreads();
#pragma unroll
    for (int mi = 0; mi < 2; ++mi)
#pragma unroll
      for (int ni = 0; ni < 2; ++ni)
#pragma unroll
        for (int i = 0; i < 4; ++i) {
          u32x2 o = {pk2(acc[mi][ni][4 * i], acc[mi][ni][4 * i + 1]), pk2(acc[mi][ni][4 * i + 2], acc[mi][ni][4 * i + 3])};
          *(u32x2*)(Qs + (64 * wn + 32 * ni + r) * 272 + (64 * wm + 32 * mi + 8 * i + 4 * g) * 2) = o;
        }
    __syncthreads();
    const int h = nt >> 1, half = nt & 1;
    const u16* PK = (const u16*)(p.ws + OFF_PK) + (size_t)(l * 2 + half) * 16384;
    unsigned z[16], y[16];
#pragma unroll
    for (int i = 0; i < 16; ++i) z[i] = 0u;
    bf16x8 qfr[8];
#pragma unroll
    for (int ks = 0; ks < 8; ++ks) qfr[ks] = *(const bf16x8*)(Qs + (32 * w + r) * 272 + (16 * ks + 8 * g) * 2);
    bf16x8 pka[8];
    const u16* pkp = PK + (size_t)r * 128 + 8 * g;
#pragma unroll
    for (int ks = 0; ks < 8; ++ks) pka[ks] = *(const bf16x8*)(pkp + 16 * ks);
#pragma unroll 1
    for (int mt = 0; mt < 4; ++mt) {
      f32x16 sc;
#pragma unroll
      for (int i = 0; i < 16; ++i) sc[i] = 0.f;
#pragma unroll
      for (int ks = 0; ks < 8; ++ks) sc = MFMA32(pka[ks], qfr[ks], sc);
      if (mt < 3) {
#pragma unroll
        for (int ks = 0; ks < 8; ++ks) pka[ks] = *(const bf16x8*)(pkp + (size_t)(32 * (mt + 1)) * 128 + 16 * ks);
      }
#pragma unroll
      for (int i = 0; i < 16; ++i) y[i] = score_key(sc[i], 32 * mt + 8 * (i >> 2) + 4 * g + (i & 3));
      sort16_desc(y);
      top16_merge(z, y);
    }
#pragma unroll
    for (int i = 0; i < 16; ++i) y[15 - i] = (unsigned)__shfl_xor((int)z[i], 32);
#pragma unroll
    for (int i = 0; i < 16; ++i) z[i] = z[i] > y[i] ? z[i] : y[i];
    merge16_desc(z);
    if (g == 0) {
      const int t = tt * 128 + 32 * w + r;
      unsigned* dst = TOPK + ((size_t)(t * 8 + h) * 2 + half) * 16;
#pragma unroll
      for (int i = 0; i < 4; ++i) { u32x4 o = {z[4 * i], z[4 * i + 1], z[4 * i + 2], z[4 * i + 3]}; *(u32x4*)(dst + 4 * i) = o; }
    }
  }
}

DI constexpr int sel_pi(int m) { return m < 16 ? 0 : m < 24 ? 1 : m < 29 ? 2 : m < 33 ? 3 : m < 36 ? 4 : m < 38 ? 5 : m < 40 ? 6 : m < 42 ? 7 : m < 50 ? m - 34 : 0; }
DI constexpr int sel_pj(int m) { return m < 16 ? m : m < 24 ? m - 16 : m < 29 ? m - 24 : m < 33 ? m - 29 : m < 36 ? m - 33 : m < 38 ? m - 36 : m < 40 ? m - 38 : m < 42 ? m - 40 : 0; }
DI unsigned sum_key(float f, int m) {
  unsigned u = __float_as_uint(f);
  u ^= (unsigned)((int)u >> 31) | 0x80000000u;
  return (u & ~63u) | (unsigned)(63 - m);
}
DI float sum_key_val(unsigned k) {
  unsigned u = k & ~63u;
  u = (u & 0x80000000u) ? (u ^ 0x80000000u) : ~u;
  return __uint_as_float(u);
}
DI void sel_phase(const Params& p, int l, char* smem) {
  const int tid = tid_opaque();
  unsigned char* s_tab = (unsigned char*)smem;
  unsigned char* s_ii = (unsigned char*)smem + 256 + tid * 32;
  __syncthreads();
  if (tid < 64) { s_tab[2 * tid] = (unsigned char)sel_pi(tid); s_tab[2 * tid + 1] = (unsigned char)sel_pj(tid); }
  __syncthreads();
  const unsigned* TOPK = (const unsigned*)(p.ws + OFF_TOPK);
  const float* SU = (const float*)(p.ws + OFF_SU) + l * 16384;
  const float* SV = (const float*)(p.ws + OFF_SV) + l * 16384;
  int* SIDX = (int*)(p.ws + OFF_SIDX); float* SW = (float*)(p.ws + OFF_SW); float* SSU = (float*)(p.ws + OFF_SSU);
  for (int item = blockIdx.x * 256 + tid; item < T * 8; item += gridDim.x * 256) {
    const unsigned* tk = TOPK + (size_t)item * 32;
    float v1[16], v2[16];
#pragma unroll
    for (int q = 0; q < 4; ++q) {
      const u32x4 a = *(const u32x4*)(tk + 4 * q), b = *(const u32x4*)(tk + 16 + 4 * q);
#pragma unroll
      for (int e = 0; e < 4; ++e) {
        v1[4 * q + e] = key_val(a[e]); s_ii[4 * q + e] = (unsigned char)(127u - (a[e] & 127u));
        v2[4 * q + e] = key_val(b[e]); s_ii[16 + 4 * q + e] = (unsigned char)(127u - (b[e] & 127u));
      }
    }
    unsigned z[16], y[16];
#pragma unroll
    for (int i = 0; i < 16; ++i) z[i] = sum_key(v1[sel_pi(i)] + v2[sel_pj(i)], i);
    sort16_desc(z);
#pragma unroll
    for (int gq = 1; gq < 4; ++gq) {
#pragma unroll
      for (int i = 0; i < 16; ++i) { const int m = 16 * gq + i; y[i] = (m < 50) ? sum_key(v1[sel_pi(m)] + v2[sel_pj(m)], m) : 0u; }
      sort16_desc(y);
      top16_merge(z, y);
    }
    const float mx = sum_key_val(z[0]);
    float ev[16], sum = 0.f;
#pragma unroll
    for (int r = 0; r < 16; ++r) { ev[r] = __expf(sum_key_val(z[r]) - mx); sum += ev[r]; }
    const float inv = 1.f / sum;
    int id[16];
#pragma unroll
    for (int r = 0; r < 16; ++r) {
      const int m = 63 - (int)(z[r] & 63u);
      const int ci = s_tab[2 * m], cj = s_tab[2 * m + 1];
      id[r] = (int)s_ii[ci] * 128 + (int)s_ii[16 + cj];
    }
#pragma unroll
    for (int q = 0; q < 4; ++q) {
      u32x4 oi; f32x4 ow, os;
#pragma unroll
      for (int e = 0; e < 4; ++e) { const int r = 4 * q + e; oi[e] = (unsigned)id[r]; ow[e] = ev[r] * inv * SV[id[r]]; os[e] = SU[id[r]]; }
      *(u32x4*)(SIDX + (size_t)item * 16 + 4 * q) = oi;
      *(f32x4*)(SW + (size_t)item * 16 + 4 * q) = ow;
      *(f32x4*)(SSU + (size_t)item * 16 + 4 * q) = os;
    }
  }
}

#ifndef VRING
#define VRING 16
#endif
#define MFMA8(a, b, c) __builtin_amdgcn_mfma_f32_16x16x32_fp8_fp8((a), (b), (c), 0, 0, 0)
DI long mk64(unsigned lo, unsigned hi) { return (long)(((unsigned long)hi << 32) | (unsigned long)lo); }
DI void e_phase(const Params& p, int l, char* smem) {
  const int tid = tid_opaque(), lane = tid & 63, w = tid >> 6;
  char* xh = smem + w * 2048;
  char* xl = xh + 1024;
  int* s_idx = (int*)(smem + 8192) + w * 128;
  float* s_w = (float*)(smem + 8192 + 2048) + w * 128;
  float* s_su = (float*)(smem + 8192 + 4096) + w * 128;
  const u16* H2 = (const u16*)(p.ws + OFF_H2);
  const int* SIDX = (const int*)(p.ws + OFF_SIDX); const float* SW = (const float*)(p.ws + OFF_SW); const float* SSU = (const float*)(p.ws + OFF_SSU);
  const unsigned char* PU = (const unsigned char*)(p.ws + OFF_PU) + (size_t)l * 16384 * 512;
  const unsigned char* PV = (const unsigned char*)(p.ws + OFF_PV) + (size_t)l * 16384 * 512;
  const float* SU = (const float*)(p.ws + OFF_SU) + l * 16384;
  const float* SV = (const float*)(p.ws + OFF_SV) + l * 16384;
  const float* X1 = (const float*)(p.ws + OFF_MIXOUT);
  u16* H = (u16*)(p.ws + OFF_H);
  const float* lg = p.ln2g + l * 1024; const float* lb = p.ln2b + l * 1024;
  int ci, cj;
  {
    const int c = lane;
    if (c < 16) { ci = 0; cj = c; } else if (c < 24) { ci = 1; cj = c - 16; } else if (c < 29) { ci = 2; cj = c - 24; }
    else if (c < 33) { ci = 3; cj = c - 29; } else if (c < 36) { ci = 4; cj = c - 33; } else if (c < 38) { ci = 5; cj = c - 36; }
    else if (c < 40) { ci = 6; cj = c - 38; } else if (c < 42) { ci = 7; cj = c - 40; } else if (c < 50) { ci = c - 34; cj = 0; }
    else { ci = 0; cj = 0; }
  }
  const bool cand_ok = lane < 50;
  const int r16 = lane & 15, kq = lane >> 4;
  for (int t = blockIdx.x * 4 + w; t < T; t += gridDim.x * 4) {
    const int l32 = lane & 31, half = lane >> 5;
    f32x2_t xv[16];
    {
      const u16* hp = H2 + (size_t)t * HP + 32 * l32;
#pragma unroll
      for (int q = 0; q < 4; ++q) {
        const u32x4 a = *(const u32x4*)(hp + 8 * q);
#pragma unroll
        for (int i = 0; i < 4; ++i) { xv[4 * q + i][0] = bflo(a[i]); xv[4 * q + i][1] = bfhi(a[i]); }
      }
    }
#pragma unroll
    for (int j = 0; j < 2; ++j) {
      const int e = lane + 64 * j;
      s_idx[e] = SIDX[(size_t)t * 128 + e]; s_w[e] = SW[(size_t)t * 128 + e]; s_su[e] = SSU[(size_t)t * 128 + e];
    }
    __builtin_amdgcn_fence(__ATOMIC_SEQ_CST, "wavefront");
    __builtin_amdgcn_wave_barrier();
    const unsigned rlo = 16u * (unsigned)l32;
    {
      const bool b4 = (lane & 16) != 0, b3 = (lane & 8) != 0, b2 = (lane & 4) != 0;
      const int eloc = 2 * ((b4 ? 4 : 0) + (b3 ? 2 : 0) + (b2 ? 1 : 0)) + half;
      u32x4 ur[8];
#pragma unroll
      for (int pq = 0; pq < 8; ++pq) ur[pq] = *(const u32x4*)(PU + ((unsigned)s_idx[2 * pq + half] * 512u + rlo));
#pragma unroll 1
      for (int g = 0; g < 8; ++g) {
        float part[8];
        const int gn = (g + 1) & 7;
#pragma unroll
        for (int pq = 0; pq < 8; ++pq) {
          const u32x4 v = ur[pq];
          if (g < 7) ur[pq] = *(const u32x4*)(PU + ((unsigned)s_idx[gn * 16 + 2 * pq + half] * 512u + rlo));
          f32x2_t accv = {0.f, 0.f};
#pragma unroll
          for (int q = 0; q < 4; ++q) {
            f32x2_t d0 = __builtin_amdgcn_cvt_scalef32_pk_f32_fp4(v[q], 1.0f, 0), d1 = __builtin_amdgcn_cvt_scalef32_pk_f32_fp4(v[q], 1.0f, 1);
            f32x2_t d2 = __builtin_amdgcn_cvt_scalef32_pk_f32_fp4(v[q], 1.0f, 2), d3 = __builtin_amdgcn_cvt_scalef32_pk_f32_fp4(v[q], 1.0f, 3);
            accv += xv[4 * q] * d0; accv += xv[4 * q + 1] * d1; accv += xv[4 * q + 2] * d2; accv += xv[4 * q + 3] * d3;
          }
          part[pq] = accv[0] + accv[1];
          asm volatile("" : "+v"(part[pq]));
        }
        float p4[4], p2[2];
#pragma unroll
        for (int i = 0; i < 4; ++i) {
          const auto sw = __builtin_amdgcn_permlane16_swap(__float_as_uint(part[i]), __float_as_uint(part[4 + i]), false, false);
          p4[i] = __uint_as_float(sw[0]) + __uint_as_float(sw[1]);
        }
#pragma unroll
        for (int i = 0; i < 2; ++i) { const float mine = b3 ? p4[2 + i] : p4[i], oth = b3 ? p4[i] : p4[2 + i]; p2[i] = mine + __shfl_xor(oth, 8); }
        float a1 = (b2 ? p2[1] : p2[0]) + __shfl_xor(b2 ? p2[0] : p2[1], 4);
        a1 += __shfl_xor(a1, 2); a1 += __shfl_xor(a1, 1);
        const int e = g * 16 + eloc;
        const float wvv = s_w[e] * gelu_tanh(s_su[e] * a1);
        __builtin_amdgcn_fence(__ATOMIC_SEQ_CST, "wavefront");
        __builtin_amdgcn_wave_barrier();
        if ((lane & 3) == 0) s_w[e] = wvv;
      }
    }
    __builtin_amdgcn_fence(__ATOMIC_SEQ_CST, "wavefront");
    __builtin_amdgcn_wave_barrier();
    float ff[16];
    {
      f32x2_t fv[16];
#pragma unroll
      for (int i = 0; i < 16; ++i) { fv[i][0] = 0.f; fv[i][1] = 0.f; }
      u32x4 vr[8];
#pragma unroll
      for (int j = 0; j < 8; ++j) vr[j] = *(const u32x4*)(PV + ((unsigned)s_idx[2 * j + half] * 512u + rlo));
#pragma unroll 1
      for (int p0 = 0; p0 < 64; p0 += 8) {
        const int pn = (p0 + 8) & 63;
#pragma unroll
        for (int j = 0; j < 8; ++j) {
          const u32x4 v = vr[j];
          vr[j] = *(const u32x4*)(PV + ((unsigned)s_idx[2 * (pn + j) + half] * 512u + rlo));
          const float we = s_w[2 * (p0 + j) + half];
          const f32x2_t we2 = {we, we};
#pragma unroll
          for (int q = 0; q < 4; ++q) {
            f32x2_t d0 = __builtin_amdgcn_cvt_scalef32_pk_f32_fp4(v[q], 1.0f, 0), d1 = __builtin_amdgcn_cvt_scalef32_pk_f32_fp4(v[q], 1.0f, 1);
            f32x2_t d2 = __builtin_amdgcn_cvt_scalef32_pk_f32_fp4(v[q], 1.0f, 2), d3 = __builtin_amdgcn_cvt_scalef32_pk_f32_fp4(v[q], 1.0f, 3);
            fv[4 * q] += we2 * d0; fv[4 * q + 1] += we2 * d1; fv[4 * q + 2] += we2 * d2; fv[4 * q + 3] += we2 * d3;
          }
          asm volatile("" : "+v"(fv[0]), "+v"(fv[1]), "+v"(fv[2]), "+v"(fv[3]), "+v"(fv[4]), "+v"(fv[5]), "+v"(fv[6]), "+v"(fv[7]),
                            "+v"(fv[8]), "+v"(fv[9]), "+v"(fv[10]), "+v"(fv[11]), "+v"(fv[12]), "+v"(fv[13]), "+v"(fv[14]), "+v"(fv[15]));
        }
      }
#pragma unroll
      for (int i = 0; i < 8; ++i) {
        const auto s0 = __builtin_amdgcn_permlane32_swap(__float_as_uint(fv[i][0]), __float_as_uint(fv[8 + i][0]), false, false);
        const auto s1 = __builtin_amdgcn_permlane32_swap(__float_as_uint(fv[i][1]), __float_as_uint(fv[8 + i][1]), false, false);
        ff[2 * i] = __uint_as_float(s0[0]) + __uint_as_float(s0[1]);
        ff[2 * i + 1] = __uint_as_float(s1[0]) + __uint_as_float(s1[1]);
      }
    }
    const int cb = 32 * l32 + 16 * half;
    __builtin_amdgcn_fence(__ATOMIC_SEQ_CST, "wavefront");
    __builtin_amdgcn_wave_barrier();
    const float* m = (const float*)(p.ws + OFF_MOD) + (size_t)(l * 9 + tok_modrow(t)) * 6144;
    float y[16];
#pragma unroll
    for (int q = 0; q < 4; ++q) {
      const int c = cb + 4 * q;
      f32x4 xv = *(const f32x4*)(X1 + (size_t)t * MP + c), g2 = *(const f32x4*)(m + 5120 + c);
#pragma unroll
      for (int e = 0; e < 4; ++e) y[4 * q + e] = ALPHA * xv[e] + g2[e] * ff[4 * q + e];
    }
    float mu, rstd; ln_stats16(y, mu, rstd);
#pragma unroll
    for (int q = 0; q < 4; ++q) {
      const int c = cb + 4 * q;
      f32x4 gv = *(const f32x4*)(lg + c), bv = *(const f32x4*)(lb + c), o;
#pragma unroll
      for (int e = 0; e < 4; ++e) { float v = (y[4 * q + e] - mu) * rstd * gv[e] + bv[e]; y[4 * q + e] = v; o[e] = v; }
      *(f32x4*)(p.out + (size_t)t * 1024 + c) = o;
    }
    if (l == 0) {
      const float* m1 = (const float*)(p.ws + OFF_MOD) + (size_t)(9 + tok_modrow(t)) * 6144;
      ln_stats16(y, mu, rstd);
#pragma unroll
      for (int hh = 0; hh < 2; ++hh) {
        const int c = cb + 8 * hh;
        f32x4 sh0 = *(const f32x4*)(m1 + c), sh1 = *(const f32x4*)(m1 + c + 4), sc0 = *(const f32x4*)(m1 + 1024 + c), sc1 = *(const f32x4*)(m1 + 1024 + c + 4);
        float hv[8];
#pragma unroll
        for (int e = 0; e < 4; ++e) {
          hv[e] = (y[8 * hh + e] - mu) * rstd * (1.f + sc0[e]) + sh0[e];
          hv[4 + e] = (y[8 * hh + 4 + e] - mu) * rstd * (1.f + sc1[e]) + sh1[e];
        }
        u32x4 o = {pk2(hv[0], hv[1]), pk2(hv[2], hv[3]), pk2(hv[4], hv[5]), pk2(hv[6], hv[7])};
        *(u32x4*)(H + (size_t)t * HP + c) = o;
      }
    }
  }
}

#define XB_TMO      128
#define XB_XCNT(j)  (256  + 64 * (j))
#define XB_XSUB(j)  (1280 + 64 * (j))
#define XB_XGEN(j)  (2304 + 64 * (j))
#define XB_TOP      3328
#define XB_TOPGEN   3392
#define XCD_BAR_WORDS 3456
#define XB_SPIN_CAP (1u << 18)
#define LAS __attribute__((address_space(3)))
__device__ __forceinline__ unsigned xb_ld(unsigned* p)              { return __hip_atomic_load(p, __ATOMIC_RELAXED, __HIP_MEMORY_SCOPE_AGENT); }
__device__ __forceinline__ unsigned xb_add(unsigned* p, unsigned v) { return __hip_atomic_fetch_add(p, v, __ATOMIC_RELAXED, __HIP_MEMORY_SCOPE_AGENT); }
__device__ __forceinline__ unsigned xb_xcc_id() { return (unsigned)__builtin_amdgcn_s_getreg((3 << 11) | 20) & 0xFu; }
#define XB_SPIN(cond, bar) do { unsigned _sp = 0; while (cond) { __builtin_amdgcn_s_sleep(1); \
    if ((++_sp & 255u) == 0u) { if (xb_ld(&(bar)[XB_TMO])) break; if (_sp > XB_SPIN_CAP) { atomicAdd(&(bar)[XB_TMO], 1u); break; } } } } while (0)
struct XcdBarrier { unsigned* bar; unsigned x; volatile LAS unsigned* st; };
__device__ __forceinline__ XcdBarrier xcd_barrier_post(unsigned* bar, volatile LAS unsigned* st) {
    XcdBarrier b; b.bar = bar; b.x = xb_xcc_id(); b.st = st;
    if (threadIdx.x == 0) (void)xb_add(&bar[XB_XCNT(b.x)], 1u);
    return b;
}
__device__ __forceinline__ void xcd_barrier_complete(unsigned* bar, unsigned x, unsigned& nloc, unsigned& nx) {
    const unsigned G = gridDim.x * gridDim.y * gridDim.z;
    unsigned sum, cnt, mine, sp = 0u;
    for (;;) {
        sum = 0u; cnt = 0u; mine = 0u;
#pragma unroll
        for (unsigned j = 0; j < 16; ++j) { const unsigned c = xb_ld(&bar[XB_XCNT(j)]); sum += c; cnt += (c > 0u) ? 1u : 0u; mine = (j == x) ? c : mine; }
        if (sum == G) break;
        __builtin_amdgcn_s_sleep(1);
        if ((++sp & 255u) == 0u) { if (xb_ld(&bar[XB_TMO])) break; if (sp > XB_SPIN_CAP) { atomicAdd(&bar[XB_TMO], 1u); break; } }
    }
    nloc = mine > 0u ? mine : 1u; nx = cnt > 0u ? cnt : 1u;
}
__device__ __forceinline__ void xcd_barrier(const XcdBarrier& b) {
    asm volatile("s_waitcnt vmcnt(0)" ::: "memory");
    __syncthreads();
    if (threadIdx.x == 0) {
        unsigned* bar = b.bar;
        __builtin_amdgcn_s_waitcnt(0);
        unsigned nloc = b.st[0], nx = b.st[1];
        if (nloc == 0u) { xcd_barrier_complete(bar, b.x, nloc, nx); b.st[0] = nloc; b.st[1] = nx; }
        const unsigned old = xb_add(&bar[XB_XSUB(b.x)], 1u);
        const unsigned gen = old / nloc;
        if (old + 1u == (gen + 1u) * nloc) {
            __builtin_amdgcn_fence(__ATOMIC_RELEASE, "agent");
            asm volatile("s_waitcnt vmcnt(0)" ::: "memory");
            const unsigned og = xb_add(&bar[XB_TOP], 1u);
            const unsigned tg = og / nx;
            if (og + 1u == (tg + 1u) * nx) xb_add(&bar[XB_TOPGEN], 1u);
            else XB_SPIN(xb_ld(&bar[XB_TOPGEN]) == tg, bar);
            __builtin_amdgcn_fence(__ATOMIC_ACQUIRE, "agent");
            xb_add(&bar[XB_XGEN(b.x)], 1u);
            asm volatile("s_waitcnt vmcnt(0)" ::: "memory");
        } else {
            XB_SPIN(xb_ld(&bar[XB_XGEN(b.x)]) == gen, bar);
            __builtin_amdgcn_fence(__ATOMIC_ACQUIRE, "agent");
            asm volatile("s_waitcnt vmcnt(0)" ::: "memory");
        }
    }
    __syncthreads();
}

constexpr int NPHASE = 2 + 2 * 9;
#ifndef PH_MASK
#define PH_MASK 2047
#endif
#ifndef PH_TWICE
#define PH_TWICE 0
#endif
__global__ void __launch_bounds__(256, 3) fwd_megakernel(Params p, int ph_lo, int ph_hi) {
  __shared__ __attribute__((aligned(16))) char smem[SMEM_BYTES];
  cg::grid_group grid = cg::this_grid();
  __shared__ uint4 xb_words;
  if (threadIdx.x == 0) xb_words = make_uint4(0u, 0u, 0u, 0u);
  __syncthreads();
  const XcdBarrier xb = xcd_barrier_post((unsigned*)(p.ws + OFF_BAR), (volatile LAS unsigned*)&xb_words);
  if (ph_lo < 0) grid.sync();
#define RUN_PH(ph, mask, call) { const int ph_ = (ph); if (ph_ >= ph_lo && ph_ < ph_hi) { if (ph_ > ph_lo) xcd_barrier(xb); if (PH_MASK & (mask)) { call; } if (PH_TWICE & (mask)) { xcd_barrier(xb); call; } } }
  RUN_PH(0, 1, prep_phase(p, smem));
  RUN_PH(1, 2, s0_phase(p));
  for (int l = 0; l < 2; ++l) {
    const int b = 2 + 9 * l;
    RUN_PH(b + 0, 4, g1_phase(p, l, smem));
    RUN_PH(b + 1, 8, r1_phase(p, l, smem));
    RUN_PH(b + 2, 16, mid_phase(p, l, smem));
    RUN_PH(b + 3, 32, attn_phase(p, smem));
    RUN_PH(b + 4, 64, g4_phase(p, l, smem));
    RUN_PH(b + 5, 128, r2_phase(p, l));
    RUN_PH(b + 6, 256, g5_phase(p, l, smem));
    RUN_PH(b + 7, 1024, sel_phase(p, l, smem));
    RUN_PH(b + 8, 512, e_phase(p, l, smem));
  }
}

#ifndef MULTI_LAUNCH
#define MULTI_LAUNCH 0
#endif

extern "C" void kernel_launch(void* const* d_in, const int* in_sizes, int n_in, void* d_out, int out_size, void* d_ws, size_t ws_size,
                              hipStream_t stream) {
  (void)in_sizes; (void)n_in; (void)out_size;
  if (ws_size < WS_NEED) { fprintf(stderr, "workspace too small: %zu < %zu\n", ws_size, (size_t)WS_NEED); return; }
  Params p{};
  const float** pp = (const float**)&p;
  for (int i = 0; i < 29; ++i) pp[i] = (const float*)d_in[i];
  p.out = (float*)d_out; p.ws = (char*)d_ws;
  static int grid_blocks = 0;
  if (!grid_blocks) {
    int dev = 0, cus = 0, per_cu = 0;
    hipGetDevice(&dev);
    hipDeviceGetAttribute(&cus, hipDeviceAttributeMultiprocessorCount, dev);
    hipOccupancyMaxActiveBlocksPerMultiprocessor(&per_cu, fwd_megakernel, 256, 0);
    if (per_cu < 1) per_cu = 1;
    grid_blocks = cus * per_cu;
  }
  hipMemsetAsync((char*)d_ws + OFF_MOD, 0, SZ_MOD + SZ_BAR, stream);
#if MULTI_LAUNCH
  for (int ph = 0; ph < NPHASE; ++ph) {
    int lo = ph, hi = ph + 1;
    hipLaunchKernelGGL(fwd_megakernel, dim3(grid_blocks), dim3(256), 0, stream, p, lo, hi);
  }
#else
  int lo = 0, hi = NPHASE;
  void* args[] = {&p, &lo, &hi};
  hipError_t e = hipLaunchCooperativeKernel((void*)fwd_megakernel, dim3(grid_blocks), dim3(256), args, 0, stream);
  if (e != hipSuccess) fprintf(stderr, "cooperative launch failed: %s (grid %d)\n", hipGetErrorString(e), grid_blocks);
#endif
}
```

```cpp
#include <hip/hip_runtime.h>
#include <hip/hip_cooperative_groups.h>
#include <cstdio>
#include <cstdint>
namespace cg = cooperative_groups;

typedef unsigned short u16;
typedef __bf16 bf16x2_t __attribute__((ext_vector_type(2)));
typedef float f32x2_t __attribute__((ext_vector_type(2)));
using bf16x8 = __attribute__((ext_vector_type(8))) short;
using f32x16 = __attribute__((ext_vector_type(16))) float;
using f32x4 = __attribute__((ext_vector_type(4))) float;
using u32x4 = __attribute__((ext_vector_type(4))) unsigned;
using u32x2 = __attribute__((ext_vector_type(2))) unsigned;
#define DI __device__ __forceinline__
#define MFMA32(a, b, c) __builtin_amdgcn_mfma_f32_32x32x16_bf16((a), (b), (c), 0, 0, 0)
#define MFMA16(a, b, c) __builtin_amdgcn_mfma_f32_16x16x32_bf16((a), (b), (c), 0, 0, 0)

constexpr int T = 24576, TC = 8192, NK = 26624, PLD = 1792;
constexpr int HP = 1088;
constexpr int WP = 1088;
constexpr int MP = 1056;
constexpr float LOG2E = 1.4426950408889634f;
constexpr float ALPHA = 1.4142135623730951f;
constexpr float EPS = 1e-6f;

struct Params {
  const float* x_prompt; const float* x_sample; const float* cache_k; const float* cache_v; const float* cache_ckv; const float* cache_kr;
  const float* c; const float* c_ctx; const float* w_mod; const float* b_mod; const float* w_in; const float* aqn; const float* akn;
  const float* mqn; const float* mkvn; const float* w_uq; const float* w_ukv; const float* gws; const float* gb; const float* w_o;
  const float* ln1g; const float* ln1b; const float* ln2g; const float* ln2b; const float* pwq; const float* pk1; const float* pk2;
  const float* pu; const float* pv;
  float* out; char* ws;
};

constexpr size_t al(size_t x) { return (x + 255) & ~(size_t)255; }
constexpr size_t OFF_MOD = 0;                        constexpr size_t SZ_MOD = (size_t)2 * 9 * 6144 * 4;
constexpr size_t OFF_BAR = OFF_MOD + SZ_MOD;          constexpr size_t SZ_BAR = (size_t)3456 * 4;
constexpr size_t OFF_R16 = al(OFF_BAR + SZ_BAR);
constexpr size_t OFF_R8 = al(OFF_R16 + 64 * 16 * 2 * 4);
constexpr size_t OFF_WIN = al(OFF_R8 + 64 * 8 * 2 * 4);
constexpr size_t OFF_WUQ = al(OFF_WIN + (size_t)2 * 1792 * WP * 2);
constexpr size_t OFF_WUKV = al(OFF_WUQ + (size_t)2 * 384 * 256 * 2);
constexpr size_t OFF_WO = al(OFF_WUKV + (size_t)2 * 512 * 128 * 2);
constexpr size_t OFF_PWQ = al(OFF_WO + (size_t)2 * 1024 * WP * 2);
constexpr size_t OFF_PK = al(OFF_PWQ + (size_t)2 * 2048 * WP * 2);
constexpr size_t OFF_GWS = al(OFF_PK + (size_t)2 * 2 * 128 * 128 * 2);
constexpr size_t OFF_PU = al(OFF_GWS + (size_t)2 * 4 * 128 * 128 * 2);
constexpr size_t OFF_PV = al(OFF_PU + (size_t)2 * 16384 * 1024);
constexpr size_t OFF_SU = al(OFF_PV + (size_t)2 * 16384 * 1024);
constexpr size_t OFF_SV = al(OFF_SU + (size_t)2 * 16384 * 4);
constexpr size_t OFF_H = al(OFF_SV + (size_t)2 * 16384 * 4);
constexpr size_t OFF_PROJ = al(OFF_H + (size_t)T * HP * 2);
constexpr size_t OFF_MIXOUT = OFF_PROJ;
constexpr size_t OFF_MIXIN = OFF_PROJ + (size_t)T * MP * 4;
constexpr size_t OFF_ATT = al(OFF_PROJ + (size_t)T * PLD * 4);
constexpr size_t OFF_QA = OFF_ATT;
constexpr size_t OFF_CQ = OFF_QA + (size_t)T * 512 * 2;
constexpr size_t OFF_UC = OFF_CQ + (size_t)T * 256 * 2;
constexpr size_t OFF_VGT = OFF_UC + (size_t)T * 256 * 2;
constexpr size_t OFF_QM = OFF_VGT + (size_t)T * 256 * 2;
constexpr size_t OFF_KA = OFF_QM + (size_t)T * 384 * 2;
constexpr size_t OFF_VAT = OFF_KA + (size_t)NK * 128 * 2;
constexpr size_t OFF_CKV = OFF_VAT + (size_t)NK * 128 * 2;
constexpr size_t OFF_KM = OFF_CKV + (size_t)NK * 128 * 2;
constexpr size_t OFF_VMT = OFF_KM + (size_t)NK * 384 * 2;
constexpr size_t OFF_ATT_END = OFF_VMT + (size_t)NK * 256 * 2;
constexpr size_t OFF_H2 = OFF_ATT;
constexpr size_t OFF_TOPK = OFF_ATT + (size_t)T * HP * 2;
constexpr size_t OFF_SIDX = OFF_TOPK + (size_t)T * 256 * 4;
constexpr size_t OFF_SW = OFF_SIDX + (size_t)T * 128 * 4;
constexpr size_t OFF_SSU = OFF_SW + (size_t)T * 128 * 4;
static_assert(OFF_SSU + (size_t)T * 128 * 4 <= OFF_ATT_END, "alias overflow 3");
constexpr size_t WS_NEED = OFF_ATT_END;
static_assert(OFF_TOPK + (size_t)T * 256 * 4 <= OFF_ATT_END, "alias overflow");
static_assert(OFF_MIXIN + (size_t)T * HP * 2 <= OFF_ATT, "alias overflow 2");

constexpr size_t OUT_K = (size_t)T * 1024;
constexpr size_t OUT_V = OUT_K + 2097152;
constexpr size_t OUT_CKV = OUT_V + 2097152;
constexpr size_t OUT_KR = OUT_CKV + 2097152;

constexpr int SMEM_BYTES = 36864;

DI int tid_opaque() { int t = threadIdx.x; asm volatile("" : "+v"(t)); return t; }
DI unsigned pk2(float a, float b) { f32x2_t v = {a, b}; bf16x2_t r = __builtin_convertvector(v, bf16x2_t); return __builtin_bit_cast(unsigned, r); }
DI float bflo(unsigned u) { return __uint_as_float(u << 16); }
DI float bfhi(unsigned u) { return __uint_as_float(u & 0xffff0000u); }
#define DPPF(v, ctrl) __int_as_float(__builtin_amdgcn_update_dpp(0, __float_as_int(v), (ctrl), 0xF, 0xF, false))
DI float wave_sum(float v) {
  v += DPPF(v, 0xB1);
  v += DPPF(v, 0x4E);
  v += DPPF(v, 0x124);
  v += DPPF(v, 0x128);
  { const auto s16 = __builtin_amdgcn_permlane16_swap(__float_as_uint(v), __float_as_uint(v), false, false); v = __uint_as_float(s16[0]) + __uint_as_float(s16[1]); }
  { const auto s32 = __builtin_amdgcn_permlane32_swap(__float_as_uint(v), __float_as_uint(v), false, false); v = __uint_as_float(s32[0]) + __uint_as_float(s32[1]); }
  return v;
}
DI float wave_max(float v) {
  v = fmaxf(v, DPPF(v, 0xB1));
  v = fmaxf(v, DPPF(v, 0x4E));
  v = fmaxf(v, DPPF(v, 0x124));
  v = fmaxf(v, DPPF(v, 0x128));
  { const auto s16 = __builtin_amdgcn_permlane16_swap(__float_as_uint(v), __float_as_uint(v), false, false); v = fmaxf(__uint_as_float(s16[0]), __uint_as_float(s16[1])); }
  { const auto s32 = __builtin_amdgcn_permlane32_swap(__float_as_uint(v), __float_as_uint(v), false, false); v = fmaxf(__uint_as_float(s32[0]), __uint_as_float(s32[1])); }
  return v;
}
DI const float* xin_row(const Params& p, int t) { return t < TC ? p.x_prompt + (size_t)t * 1024 : p.x_sample + (size_t)(t - TC) * 1024; }
DI int tok_modrow(int t) { return t < TC ? 0 : 1 + ((t - TC) >> 11); }
DI int tok_keyrow(int t) { if (t < TC) return t; int u = t - TC; return TC + (u >> 11) * 2304 + 256 + (u & 2047); }
DI size_t vt_index(int kr, int ch, int C) {
  if (kr < TC) return ((size_t)((kr >> 8) * C + ch)) * 256 + (kr & 255);
  int u = kr - TC; int bl = u / 2304; int pos = u - bl * 2304;
  return (size_t)32 * C * 256 + ((size_t)(bl * C + ch)) * 2304 + pos;
}
DI float gelu_tanh(float x) {
  float u = 0.7978845608028654f * (x + 0.044715f * x * x * x);
  float e = __expf(2.f * u);
  float th = 1.f - 2.f * __builtin_amdgcn_rcpf(e + 1.f);
  return 0.5f * x * (1.f + th);
}

DI void ln_stats16(const float (&x)[16], float& mu, float& rstd) {
  float s = 0.f;
#pragma unroll
  for (int i = 0; i < 16; ++i) s += x[i];
  s = wave_sum(s); mu = s * (1.f / 1024.f);
  float q = 0.f;
#pragma unroll
  for (int i = 0; i < 16; ++i) { float d = x[i] - mu; q += d * d; }
  q = wave_sum(q);
  rstd = rsqrtf(q * (1.f / 1024.f) + EPS);
}

DI void transpose_tile(const float* __restrict__ src, int N, u16* __restrict__ dst, int ldd, int k0, int n0, char* smem) {
  float* s = (float*)smem;
  const int tid = tid_opaque();
  __syncthreads();
#pragma unroll
  for (int it = 0; it < 4; ++it) {
    int kk = (tid >> 4) + 16 * it, cn = (tid & 15) * 4;
    f32x4 v = {0.f, 0.f, 0.f, 0.f};
    if (n0 + cn < N) v = *(const f32x4*)(src + (size_t)(k0 + kk) * N + n0 + cn);
    s[kk * 65 + cn + 0] = v[0]; s[kk * 65 + cn + 1] = v[1]; s[kk * 65 + cn + 2] = v[2]; s[kk * 65 + cn + 3] = v[3];
  }
  __syncthreads();
#pragma unroll
  for (int it = 0; it < 2; ++it) {
    int id = tid + 256 * it, n = id >> 3, kc = id & 7;
    if (n0 + n < N) {
      u32x4 o;
#pragma unroll
      for (int e = 0; e < 4; ++e) o[e] = pk2(s[(kc * 8 + 2 * e) * 65 + n], s[(kc * 8 + 2 * e + 1) * 65 + n]);
      *(u32x4*)(dst + (size_t)(n0 + n) * ldd + k0 + kc * 8) = o;
    }
  }
}

DI void convert_task(const float* __restrict__ src, u16* __restrict__ dst, size_t base) {
  const int tid = tid_opaque();
#pragma unroll
  for (int it = 0; it < 2; ++it) {
    size_t i = base + (size_t)(it * 256 + tid) * 8;
    f32x4 a = *(const f32x4*)(src + i), b = *(const f32x4*)(src + i + 4);
    u32x4 o = {pk2(a[0], a[1]), pk2(a[2], a[3]), pk2(b[0], b[1]), pk2(b[2], b[3])};
    *(u32x4*)(dst + i) = o;
  }
}

DI void quant_rows_task(const float* __restrict__ src, unsigned char* __restrict__ dst, float* __restrict__ scl, int row0) {
  const int tid = tid_opaque(), lane = tid & 63, w = tid >> 6;
#pragma unroll 2
  for (int q = 0; q < 8; ++q) {
    const int row = row0 + w * 8 + q;
    const float* sp = src + (size_t)row * 1024 + lane * 16;
    f32x4 v[4];
    float am = 0.f;
#pragma unroll
    for (int i = 0; i < 4; ++i) { v[i] = *(const f32x4*)(sp + 4 * i); am = fmaxf(am, fmaxf(fmaxf(fabsf(v[i][0]), fabsf(v[i][1])), fmaxf(fabsf(v[i][2]), fabsf(v[i][3])))); }
    am = wave_max(am);
    const float sc = am > 0.f ? am * (1.f / 400.f) : 1.f;
    const float inv = 1.f / sc;
    u32x4 o;
#pragma unroll
    for (int i = 0; i < 4; ++i) {
      int wd = __builtin_amdgcn_cvt_pk_fp8_f32(v[i][0] * inv, v[i][1] * inv, 0, false);
      wd = __builtin_amdgcn_cvt_pk_fp8_f32(v[i][2] * inv, v[i][3] * inv, wd, true);
      o[i] = (unsigned)wd;
    }
    *(u32x4*)(dst + (size_t)row * 1024 + lane * 16) = o;
    if (lane == 0) scl[row] = sc;
  }
}

DI void quant_rows_fp4_task(const float* __restrict__ src, unsigned char* __restrict__ dst, float* __restrict__ scl, int row0) {
  const int tid = tid_opaque(), lane = tid & 63, w = tid >> 6;
#pragma unroll 2
  for (int q = 0; q < 8; ++q) {
    const int row = row0 + w * 8 + q;
    const float* sp = src + (size_t)row * 1024 + lane * 16;
    f32x4 v[4];
    float am = 0.f;
#pragma unroll
    for (int i = 0; i < 4; ++i) { v[i] = *(const f32x4*)(sp + 4 * i); am = fmaxf(am, fmaxf(fmaxf(fabsf(v[i][0]), fabsf(v[i][1])), fmaxf(fabsf(v[i][2]), fabsf(v[i][3])))); }
    am = wave_max(am);
    const float sc = am > 0.f ? am * (1.f / 6.f) : 1.f;
    const float inv = 1.f / sc;
    u32x2 o;
#pragma unroll
    for (int j = 0; j < 2; ++j) {
      unsigned wd = 0u;
      wd = __builtin_amdgcn_cvt_scalef32_pk_fp4_f32(wd, v[2 * j][0] * inv, v[2 * j][1] * inv, 1.0f, 0);
      wd = __builtin_amdgcn_cvt_scalef32_pk_fp4_f32(wd, v[2 * j][2] * inv, v[2 * j][3] * inv, 1.0f, 1);
      wd = __builtin_amdgcn_cvt_scalef32_pk_fp4_f32(wd, v[2 * j + 1][0] * inv, v[2 * j + 1][1] * inv, 1.0f, 2);
      wd = __builtin_amdgcn_cvt_scalef32_pk_fp4_f32(wd, v[2 * j + 1][2] * inv, v[2 * j + 1][3] * inv, 1.0f, 3);
      o[j] = wd;
    }
    *(u32x2*)(dst + (size_t)row * 512 + lane * 8) = o;
    if (lane == 0) scl[row] = sc;
  }
}

DI void prep_phase(const Params& p, char* smem) {
  const int tid = tid_opaque();
  constexpr int N_MOD = 768, N_TR_L = 1240, N_TR = 2 * N_TR_L;
  constexpr int B_TR = N_MOD, B_PK = B_TR + N_TR, B_GWS = B_PK + 16, B_PU = B_GWS + 32, B_PV = B_PU + 1024, B_ZP = B_PV + 1024, B_RT = B_ZP + 2, N_ALL = B_RT + 1;
  for (int task = blockIdx.x; task < N_ALL; task += gridDim.x) {
    if (task < B_TR) {
      const int l = task / 384, rem = task % 384, nc = rem >> 4, kc = rem & 15;
      float* sc = (float*)smem;
      __syncthreads();
      for (int e = tid; e < 576; e += 256) {
        int r = e >> 6, k = e & 63;
        float v = (r == 0) ? p.c_ctx[kc * 64 + k] : p.c[(r - 1) * 1024 + kc * 64 + k];
        sc[e] = v / (1.f + __expf(-v));
      }
      __syncthreads();
      const int n = nc * 256 + tid;
      const float* w = p.w_mod + ((size_t)l * 1024 + kc * 64) * 6144 + n;
      float acc[9];
#pragma unroll
      for (int r = 0; r < 9; ++r) acc[r] = 0.f;
#pragma unroll 8
      for (int k = 0; k < 64; ++k) {
        float wv = w[(size_t)k * 6144];
#pragma unroll
        for (int r = 0; r < 9; ++r) acc[r] += sc[r * 64 + k] * wv;
      }
      float* mod = (float*)(p.ws + OFF_MOD) + (size_t)l * 9 * 6144;
      float bias = (kc == 0) ? p.b_mod[l * 6144 + n] : 0.f;
#pragma unroll
      for (int r = 0; r < 9; ++r) unsafeAtomicAdd(&mod[r * 6144 + n], acc[r] + bias);
    } else if (task < B_PK) {
      int j = task - B_TR; const int l = j / N_TR_L; int r = j % N_TR_L;
      if (r < 432) { int kt = r / 27, nt = r % 27; transpose_tile(p.w_in + (size_t)l * 1024 * 1696, 1696, (u16*)(p.ws + OFF_WIN) + (size_t)l * 1792 * WP, WP, kt * 64, nt * 64, smem); }
      else if (r < 456) { r -= 432; int kt = r / 6, nt = r % 6; transpose_tile(p.w_uq + (size_t)l * 256 * 384, 384, (u16*)(p.ws + OFF_WUQ) + (size_t)l * 384 * 256, 256, kt * 64, nt * 64, smem); }
      else if (r < 472) { r -= 456; int kt = r / 8, nt = r % 8; transpose_tile(p.w_ukv + (size_t)l * 128 * 512, 512, (u16*)(p.ws + OFF_WUKV) + (size_t)l * 512 * 128, 128, kt * 64, nt * 64, smem); }
      else if (r < 728) { r -= 472; int kt = r / 16, nt = r % 16; transpose_tile(p.w_o + (size_t)l * 1024 * 1024, 1024, (u16*)(p.ws + OFF_WO) + (size_t)l * 1024 * WP, WP, kt * 64, nt * 64, smem); }
      else { r -= 728; int kt = r / 32, nt = r % 32; transpose_tile(p.pwq + (size_t)l * 1024 * 2048, 2048, (u16*)(p.ws + OFF_PWQ) + (size_t)l * 2048 * WP, WP, kt * 64, nt * 64, smem); }
    } else if (task < B_GWS) {
      int j = task - B_PK;
      int l = j >> 3, half = (j >> 2) & 1, ch = j & 3;
      const float* src = (half ? p.pk2 : p.pk1) + (size_t)l * 16384;
      convert_task(src, (u16*)(p.ws + OFF_PK) + (size_t)(l * 2 + half) * 16384, (size_t)ch * 4096);
    } else if (task < B_PU) {
      convert_task(p.gws, (u16*)(p.ws + OFF_GWS), (size_t)(task - B_GWS) * 4096);
    } else if (task < B_PV) {
      quant_rows_fp4_task(p.pu, (unsigned char*)(p.ws + OFF_PU), (float*)(p.ws + OFF_SU), (task - B_PU) * 32);
    } else if (task < B_ZP) {
      quant_rows_fp4_task(p.pv, (unsigned char*)(p.ws + OFF_PV), (float*)(p.ws + OFF_SV), (task - B_PV) * 32);
    } else if (task < B_RT) {
      int l = task - B_ZP;
      u16* dst = (u16*)(p.ws + OFF_WIN) + ((size_t)l * 1792 + 1696) * WP;
      u32x4 z = {0u, 0u, 0u, 0u};
      for (int c = tid; c < 96 * WP / 8; c += 256) *(u32x4*)(dst + (size_t)c * 8) = z;
    } else {
      float* r16 = (float*)(p.ws + OFF_R16); float* r8 = (float*)(p.ws + OFF_R8);
      for (int e = tid; e < 1024; e += 256) {
        int pos = e >> 4, f = e & 15;
        float fr = exp2f(-(float)f * (13.287712379549449f / 16.f));
        float ang = (float)pos * fr;
        r16[e * 2] = __cosf(ang); r16[e * 2 + 1] = __sinf(ang);
      }
      for (int e = tid; e < 512; e += 256) {
        int pos = e >> 3, f = e & 7;
        float fr = exp2f(-(float)f * (13.287712379549449f / 8.f));
        float ang = (float)pos * fr;
        r8[e * 2] = __cosf(ang); r8[e * 2 + 1] = __sinf(ang);
      }
    }
  }
}


DI void s0_phase(const Params& p) {
  const int lane = tid_opaque() & 63, w = tid_opaque() >> 6;
  u16* H = (u16*)(p.ws + OFF_H);
  for (int t = blockIdx.x * 4 + w; t < T; t += gridDim.x * 4) {
    const float* xr = xin_row(p, t);
    float x[16];
#pragma unroll
    for (int i = 0; i < 4; ++i) { f32x4 v = *(const f32x4*)(xr + 4 * (lane + 64 * i)); x[4 * i] = v[0]; x[4 * i + 1] = v[1]; x[4 * i + 2] = v[2]; x[4 * i + 3] = v[3]; }
    float mu, rstd; ln_stats16(x, mu, rstd);
    const float* m = (const float*)(p.ws + OFF_MOD) + (size_t)tok_modrow(t) * 6144;
#pragma unroll
    for (int i = 0; i < 4; ++i) {
      int c = 4 * (lane + 64 * i);
      f32x4 sh = *(const f32x4*)(m + c), sc = *(const f32x4*)(m + 1024 + c);
      float h0 = (x[4 * i] - mu) * rstd * (1.f + sc[0]) + sh[0];
      float h1 = (x[4 * i + 1] - mu) * rstd * (1.f + sc[1]) + sh[1];
      float h2 = (x[4 * i + 2] - mu) * rstd * (1.f + sc[2]) + sh[2];
      float h3 = (x[4 * i + 3] - mu) * rstd * (1.f + sc[3]) + sh[3];
      u32x2 o = {pk2(h0, h1), pk2(h2, h3)};
      *(u32x2*)(H + (size_t)t * HP + c) = o;
    }
  }
}

DI void gemm_mainloop(const u16* __restrict__ A, int lda, const u16* __restrict__ B, int ldb, int K, char* smem, f32x16 (&acc)[2][2], int nact = 4) {
  const int tid = tid_opaque(), lane = tid & 63, w = tid >> 6, wm = w >> 1, wn = w & 1, r = lane & 31, g = lane >> 5;
  char* As = smem; char* Bs = smem + 128 * 144;
#pragma unroll
  for (int mi = 0; mi < 2; ++mi)
#pragma unroll
    for (int ni = 0; ni < 2; ++ni)
#pragma unroll
      for (int i = 0; i < 16; ++i) acc[mi][ni][i] = 0.f;
  u32x4 ra[4], rb[4];
  const int lrow = tid >> 3, lkc = tid & 7;
  const u16* ga = A + (size_t)lrow * lda + lkc * 8;
  const u16* gb = B + (size_t)lrow * ldb + lkc * 8;
#pragma unroll
  for (int i = 0; i < 4; ++i) { ra[i] = *(const u32x4*)(ga + (size_t)(32 * i) * lda); rb[i] = *(const u32x4*)(gb + (size_t)(32 * i) * ldb); }
  for (int k0 = 0; k0 < K; k0 += 64) {
    __syncthreads();
#pragma unroll
    for (int i = 0; i < 4; ++i) {
      *(u32x4*)(As + (lrow + 32 * i) * 144 + lkc * 16) = ra[i];
      *(u32x4*)(Bs + (lrow + 32 * i) * 144 + lkc * 16) = rb[i];
    }
    __syncthreads();
    if (k0 + 64 < K) {
#pragma unroll
      for (int i = 0; i < 4; ++i) { ra[i] = *(const u32x4*)(ga + (size_t)(32 * i) * lda + k0 + 64); rb[i] = *(const u32x4*)(gb + (size_t)(32 * i) * ldb + k0 + 64); }
    }
    __builtin_amdgcn_s_setprio(2);
    if (2 * wm + 1 < nact) {
#pragma unroll
      for (int ks = 0; ks < 4; ++ks) {
        bf16x8 af[2], bfr[2];
#pragma unroll
        for (int mi = 0; mi < 2; ++mi) af[mi] = *(const bf16x8*)(As + (64 * wm + 32 * mi + r) * 144 + (16 * ks + 8 * g) * 2);
#pragma unroll
        for (int ni = 0; ni < 2; ++ni) bfr[ni] = *(const bf16x8*)(Bs + (64 * wn + 32 * ni + r) * 144 + (16 * ks + 8 * g) * 2);
#pragma unroll
        for (int mi = 0; mi < 2; ++mi)
#pragma unroll
          for (int ni = 0; ni < 2; ++ni) acc[mi][ni] = MFMA32(af[mi], bfr[ni], acc[mi][ni]);
      }
    } else if (2 * wm < nact) {
#pragma unroll
      for (int ks = 0; ks < 4; ++ks) {
        const bf16x8 af0 = *(const bf16x8*)(As + (64 * wm + r) * 144 + (16 * ks + 8 * g) * 2);
#pragma unroll
        for (int ni = 0; ni < 2; ++ni) {
          const bf16x8 bf0 = *(const bf16x8*)(Bs + (64 * wn + 32 * ni + r) * 144 + (16 * ks + 8 * g) * 2);
          acc[0][ni] = MFMA32(af0, bf0, acc[0][ni]);
        }
      }
    }
    __builtin_amdgcn_s_setprio(0);
  }
}

DI void epi_store_f32(const f32x16 (&acc)[2][2], float* __restrict__ C, int ldc, int n0, int t0) {
  const int lane = tid_opaque() & 63, w = tid_opaque() >> 6, wm = w >> 1, wn = w & 1, r = lane & 31, g = lane >> 5;
#pragma unroll
  for (int mi = 0; mi < 2; ++mi)
#pragma unroll
    for (int ni = 0; ni < 2; ++ni) {
      const int t = t0 + 64 * wn + 32 * ni + r;
#pragma unroll
      for (int i = 0; i < 4; ++i) {
        const int n = n0 + 64 * wm + 32 * mi + 8 * i + 4 * g;
        f32x4 v = {acc[mi][ni][4 * i], acc[mi][ni][4 * i + 1], acc[mi][ni][4 * i + 2], acc[mi][ni][4 * i + 3]};
        *(f32x4*)(C + (size_t)t * ldc + n) = v;
      }
    }
}

DI void g1_phase(const Params& p, int l, char* smem) {
  const u16* W = (const u16*)(p.ws + OFF_WIN) + (size_t)l * 1792 * WP;
  const u16* H = (const u16*)(p.ws + OFF_H);
  float* PROJ = (float*)(p.ws + OFF_PROJ);
  const int xq = blockIdx.x & 7, qq = blockIdx.x >> 3, nbx = (int)((gridDim.x - xq + 7) >> 3);
  for (int i = qq; i < 24 * 14; i += nbx) {
    const int tt = (i / 14) * 8 + xq, nt = i % 14;
    f32x16 acc[2][2];
    gemm_mainloop(W + (size_t)nt * 128 * WP, WP, H + (size_t)tt * 128 * HP, HP, 1024, smem, acc, nt == 13 ? 1 : 4);
    epi_store_f32(acc, PROJ, PLD, nt * 128, tt * 128);
  }
}

DI void rope16_apply(float (&v)[8], int c, int rowp, int colp, const float* __restrict__ r16) {
  const int pos = (c < 4) ? rowp : colp;
  const float* tb = r16 + (size_t)(pos * 16 + (c & 1) * 8) * 2;
  const bool is_x1 = (c & 2) == 0;
#pragma unroll
  for (int e = 0; e < 8; ++e) {
    float pv = __shfl_xor(v[e], 2);
    float cs = tb[2 * e], sn = tb[2 * e + 1];
    v[e] = is_x1 ? (v[e] * cs - pv * sn) : (pv * sn + v[e] * cs);
  }
}

DI void r1_phase(const Params& p, int l, char* smem) {
  const int tid = tid_opaque(), lane = tid & 63, w = tid >> 6;
  u16* sT = (u16*)smem;
  const float* PROJ = (const float*)(p.ws + OFF_PROJ);
  const float* r16 = (const float*)(p.ws + OFF_R16);
  const float* r8 = (const float*)(p.ws + OFF_R8);
  u16* QA = (u16*)(p.ws + OFF_QA); u16* CQ = (u16*)(p.ws + OFF_CQ); u16* UC = (u16*)(p.ws + OFF_UC); u16* VGT = (u16*)(p.ws + OFF_VGT);
  u16* KA = (u16*)(p.ws + OFF_KA); u16* VAT = (u16*)(p.ws + OFF_VAT); u16* CKV = (u16*)(p.ws + OFF_CKV); u16* KM = (u16*)(p.ws + OFF_KM);
  const float* aqn = p.aqn + l * 64; const float* akn = p.akn + l * 64; const float* mqn = p.mqn + l * 256; const float* mkvn = p.mkvn + l * 128;
  constexpr int NTB = T / 32;
  for (int task0 = blockIdx.x; task0 < NTB + 64; task0 += gridDim.x) {
    const int task = (task0 < 64) ? (NTB + task0) : (task0 - 64);
    __syncthreads();
    if (task < NTB) {
      const int t0 = task * 32;
      for (int q = 0; q < 8; ++q) {
        const int tl = w * 8 + q, t = t0 + tl;
        const float* pr = PROJ + (size_t)t * PLD;
        const bool lat = t >= TC;
        const int s = lat ? ((t - TC) & 2047) : (t & 255);
        const int bctx = t >> 8;
        const int rowp = s >> 6, colp = s & 63;
        const int kr = tok_keyrow(t);
        const int c = lane & 7;
        {
          f32x4 a = *(const f32x4*)(pr + lane * 8), b = *(const f32x4*)(pr + lane * 8 + 4);
          float v[8] = {a[0], a[1], a[2], a[3], b[0], b[1], b[2], b[3]};
          float ss = 0.f;
#pragma unroll
          for (int e = 0; e < 8; ++e) ss += v[e] * v[e];
          ss += __shfl_xor(ss, 1); ss += __shfl_xor(ss, 2); ss += __shfl_xor(ss, 4);
          float rinv = rsqrtf(ss * (1.f / 64.f) + EPS);
#pragma unroll
          for (int e = 0; e < 8; ++e) v[e] = v[e] * rinv * aqn[c * 8 + e];
          if (lat) rope16_apply(v, c, rowp, colp, r16);
          const float sc = 0.125f * LOG2E;
          u32x4 o = {pk2(v[0] * sc, v[1] * sc), pk2(v[2] * sc, v[3] * sc), pk2(v[4] * sc, v[5] * sc), pk2(v[6] * sc, v[7] * sc)};
          *(u32x4*)(QA + (size_t)t * 512 + lane * 8) = o;
        }
        {
          const int ln = lane & 31;
          f32x4 a = *(const f32x4*)(pr + 512 + ln * 8), b = *(const f32x4*)(pr + 512 + ln * 8 + 4);
          float v[8] = {a[0], a[1], a[2], a[3], b[0], b[1], b[2], b[3]};
          float ss = 0.f;
#pragma unroll
          for (int e = 0; e < 8; ++e) ss += v[e] * v[e];
          ss += __shfl_xor(ss, 1); ss += __shfl_xor(ss, 2); ss += __shfl_xor(ss, 4);
          float rinv = rsqrtf(ss * (1.f / 64.f) + EPS);
          float kv[8];
#pragma unroll
          for (int e = 0; e < 8; ++e) kv[e] = v[e] * rinv * akn[c * 8 + e];
          if (!lat && lane < 16) {
            float* o = p.out + OUT_K + ((size_t)((bctx * 2 + l) * 256 + s)) * 128 + lane * 8;
            f32x4 o0 = {kv[0], kv[1], kv[2], kv[3]}, o1 = {kv[4], kv[5], kv[6], kv[7]};
            *(f32x4*)o = o0; *(f32x4*)(o + 4) = o1;
          }
          if (lat) rope16_apply(kv, c, rowp, colp, r16);
          if (lane < 16) {
            u32x4 o = {pk2(kv[0], kv[1]), pk2(kv[2], kv[3]), pk2(kv[4], kv[5]), pk2(kv[6], kv[7])};
            *(u32x4*)(KA + (size_t)kr * 128 + lane * 8) = o;
          } else if (lane < 32) {
            const int ch = (lane - 16) * 8;
            if (!lat) {
              float* o = p.out + OUT_V + ((size_t)((bctx * 2 + l) * 256 + s)) * 128 + ch;
              *(f32x4*)o = a; *(f32x4*)(o + 4) = b;
            }
#pragma unroll
            for (int e = 0; e < 8; ++e) sT[(ch + e) * 40 + tl] = (u16)(pk2(v[e], 0.f) & 0xffffu);
          }
        }
        {
          f32x4 a = *(const f32x4*)(pr + 768 + lane * 4);
          float ss = a[0] * a[0] + a[1] * a[1] + a[2] * a[2] + a[3] * a[3];
          ss = wave_sum(ss);
          float rinv = rsqrtf(ss * (1.f / 256.f) + EPS);
          f32x4 gq = *(const f32x4*)(mqn + lane * 4);
          u32x2 o = {pk2(a[0] * rinv * gq[0], a[1] * rinv * gq[1]), pk2(a[2] * rinv * gq[2], a[3] * rinv * gq[3])};
          *(u32x2*)(CQ + (size_t)t * 256 + lane * 4) = o;
        }
        {
          f32x2_t a = *(const f32x2_t*)(pr + 1024 + lane * 2);
          float ss = wave_sum(a[0] * a[0] + a[1] * a[1]);
          float rinv = rsqrtf(ss * (1.f / 128.f) + EPS);
          float c0 = a[0] * rinv * mkvn[lane * 2], c1 = a[1] * rinv * mkvn[lane * 2 + 1];
          if (!lat) { f32x2_t o = {c0, c1}; *(f32x2_t*)(p.out + OUT_CKV + ((size_t)((bctx * 2 + l) * 256 + s)) * 128 + lane * 2) = o; }
          *(unsigned*)(CKV + (size_t)kr * 128 + lane * 2) = pk2(c0, c1);
        }
        {
          const int ln = lane & 31;
          float v = pr[1152 + ln];
          if (!lat && lane < 32) p.out[OUT_KR + ((size_t)((bctx * 2 + l) * 256 + s)) * 32 + ln] = v;
          if (lat) {
            float pv = __shfl_xor(v, 8);
            const int pos = (ln >> 4) ? colp : rowp;
            const float* tb = r8 + (size_t)(pos * 8 + (ln & 7)) * 2;
            float cs = tb[0], sn = tb[1];
            v = (ln & 8) ? (pv * sn + v * cs) : (v * cs - pv * sn);
          }
          if (lane < 32) {
            u16 hv = (u16)(pk2(v, 0.f) & 0xffffu);
#pragma unroll
            for (int h = 0; h < 4; ++h) KM[(size_t)kr * 384 + h * 96 + 64 + ln] = hv;
          }
        }
        {
          f32x4 a = *(const f32x4*)(pr + 1184 + lane * 4);
          u32x2 o = {pk2(a[0], a[1]), pk2(a[2], a[3])};
          *(u32x2*)(UC + (size_t)t * 256 + lane * 4) = o;
        }
        {
          f32x4 a = *(const f32x4*)(pr + 1440 + lane * 4);
          float sm = a[0] + a[1] + a[2] + a[3];
          sm += __shfl_xor(sm, 1); sm += __shfl_xor(sm, 2); sm += __shfl_xor(sm, 4); sm += __shfl_xor(sm, 8);
          float mu = sm * (1.f / 64.f);
          float d0 = a[0] - mu, d1 = a[1] - mu, d2 = a[2] - mu, d3 = a[3] - mu;
          float q2 = d0 * d0 + d1 * d1 + d2 * d2 + d3 * d3;
          q2 += __shfl_xor(q2, 1); q2 += __shfl_xor(q2, 2); q2 += __shfl_xor(q2, 4); q2 += __shfl_xor(q2, 8);
          float rstd = rsqrtf(q2 * (1.f / 64.f) + EPS);
          unsigned u0 = pk2(d0 * rstd, d1 * rstd), u1 = pk2(d2 * rstd, d3 * rstd);
          const int ch = 128 + lane * 4;
          sT[(ch + 0) * 40 + tl] = (u16)(u0 & 0xffffu); sT[(ch + 1) * 40 + tl] = (u16)(u0 >> 16);
          sT[(ch + 2) * 40 + tl] = (u16)(u1 & 0xffffu); sT[(ch + 3) * 40 + tl] = (u16)(u1 >> 16);
        }
      }
      __syncthreads();
      const int kr0 = tok_keyrow(t0);
      const int chunk = t0 >> 7, q0 = t0 & 127;
#pragma unroll
      for (int it = 0; it < 6; ++it) {
        int id = tid + 256 * it, row = id >> 2, cc = id & 3;
        u32x4 v = *(const u32x4*)(sT + row * 40 + cc * 8);
        if (row < 128) *(u32x4*)(VAT + vt_index(kr0, row, 128) + cc * 8) = v;
        else { int gd = row - 128; *(u32x4*)(VGT + ((size_t)(chunk * 256 + gd)) * 128 + q0 + cc * 8) = v; }
      }
    } else {
      const int j = task - NTB, bl = j >> 3, p0 = (j & 7) * 32;
      for (int q = 0; q < 8; ++q) {
        const int tl = w * 8 + q, pp = p0 + tl;
        const size_t crow = (size_t)((bl * 2 + l) * 256 + pp);
        const int kr = TC + bl * 2304 + pp;
        f32x2_t k2 = *(const f32x2_t*)(p.cache_k + crow * 128 + lane * 2);
        *(unsigned*)(KA + (size_t)kr * 128 + lane * 2) = pk2(k2[0], k2[1]);
        f32x2_t v2 = *(const f32x2_t*)(p.cache_v + crow * 128 + lane * 2);
        unsigned uv = pk2(v2[0], v2[1]);
        sT[(lane * 2) * 40 + tl] = (u16)(uv & 0xffffu); sT[(lane * 2 + 1) * 40 + tl] = (u16)(uv >> 16);
        f32x2_t c2 = *(const f32x2_t*)(p.cache_ckv + crow * 128 + lane * 2);
        *(unsigned*)(CKV + (size_t)kr * 128 + lane * 2) = pk2(c2[0], c2[1]);
        if (lane < 32) {
          float v = p.cache_kr[crow * 32 + lane];
          u16 hv = (u16)(pk2(v, 0.f) & 0xffffu);
#pragma unroll
          for (int h = 0; h < 4; ++h) KM[(size_t)kr * 384 + h * 96 + 64 + lane] = hv;
        }
      }
      __syncthreads();
      const int kr0 = TC + bl * 2304 + p0;
#pragma unroll
      for (int it = 0; it < 2; ++it) {
        int id = tid + 256 * it, row = id >> 2, cc = id & 3;
        u32x4 v = *(const u32x4*)(sT + row * 40 + cc * 8);
        *(u32x4*)(VAT + vt_index(kr0, row, 128) + cc * 8) = v;
      }
    }
  }
}

DI void mid_phase(const Params& p, int l, char* smem) {
  const int tid = tid_opaque(), lane = tid & 63, w = tid >> 6, wm = w >> 1, wn = w & 1, r = lane & 31, g = lane >> 5;
  constexpr int N_G2 = 192 * 3, N_G3 = 208 * 4, N_C1 = 192 * 4;
  for (int task = blockIdx.x; task < N_G2 + N_G3 + N_C1; task += gridDim.x) {
    if (task < N_G2) {
      const int tt = task / 3, nt = task % 3;
      const u16* W = (const u16*)(p.ws + OFF_WUQ) + (size_t)l * 384 * 256;
      const u16* CQ = (const u16*)(p.ws + OFF_CQ);
      u16* QM = (u16*)(p.ws + OFF_QM);
      const float* r8 = (const float*)(p.ws + OFF_R8);
      f32x16 acc[2][2];
      gemm_mainloop(W + (size_t)nt * 128 * 256, 256, CQ + (size_t)tt * 128 * 256, 256, 256, smem, acc);
      const float sc = LOG2E * 0.10206207261596577f;
#pragma unroll
      for (int mi = 0; mi < 2; ++mi) {
        const int nb = nt * 128 + 64 * wm + 32 * mi;
        const bool is_rope = (nb % 96) == 64;
#pragma unroll
        for (int ni = 0; ni < 2; ++ni) {
          const int t = tt * 128 + 64 * wn + 32 * ni + r;
          float v[16];
#pragma unroll
          for (int i = 0; i < 16; ++i) v[i] = acc[mi][ni][i];
          if (is_rope && t >= TC) {
            const int s = (t - TC) & 2047, rowp = s >> 6, colp = s & 63;
#pragma unroll
            for (int j = 0; j < 4; ++j) {
              const float* tb = r8 + (size_t)(rowp * 8 + 4 * g + j) * 2;
              float cs = tb[0], sn = tb[1];
              float x1 = v[j], x2 = v[4 + j];
              v[j] = x1 * cs - x2 * sn; v[4 + j] = x1 * sn + x2 * cs;
              const float* tc = r8 + (size_t)(colp * 8 + 4 * g + j) * 2;
              cs = tc[0]; sn = tc[1];
              x1 = v[8 + j]; x2 = v[12 + j];
              v[8 + j] = x1 * cs - x2 * sn; v[12 + j] = x1 * sn + x2 * cs;
            }
          }
#pragma unroll
          for (int i = 0; i < 4; ++i) {
            u32x2 o = {pk2(v[4 * i] * sc, v[4 * i + 1] * sc), pk2(v[4 * i + 2] * sc, v[4 * i + 3] * sc)};
            *(u32x2*)(QM + (size_t)t * 384 + nb + 8 * i + 4 * g) = o;
          }
        }
      }
    } else if (task < N_G2 + N_G3) {
      const int j = task - N_G2, tt = j >> 2, h = j & 3;
      const u16* W = (const u16*)(p.ws + OFF_WUKV) + (size_t)l * 512 * 128;
      const u16* CKV = (const u16*)(p.ws + OFF_CKV);
      u16* KM = (u16*)(p.ws + OFF_KM); u16* VMT = (u16*)(p.ws + OFF_VMT);
      f32x16 acc[2][2];
      gemm_mainloop(W + (size_t)h * 128 * 128, 128, CKV + (size_t)tt * 128 * 128, 128, 128, smem, acc);
#pragma unroll
      for (int mi = 0; mi < 2; ++mi)
#pragma unroll
        for (int ni = 0; ni < 2; ++ni) {
          const int kr = tt * 128 + 64 * wn + 32 * ni + r;
          if (wm == 0) {
#pragma unroll
            for (int i = 0; i < 4; ++i) {
              u32x2 o = {pk2(acc[mi][ni][4 * i], acc[mi][ni][4 * i + 1]), pk2(acc[mi][ni][4 * i + 2], acc[mi][ni][4 * i + 3])};
              *(u32x2*)(KM + (size_t)kr * 384 + h * 96 + 32 * mi + 8 * i + 4 * g) = o;
            }
          } else {
            size_t vbase; int lseq;
            if (kr < TC) { vbase = (size_t)(kr >> 8) * 256 * 256 + (kr & 255); lseq = 256; }
            else { const int u = kr - TC, bl = u / 2304, pos = u - bl * 2304; vbase = (size_t)32 * 256 * 256 + (size_t)bl * 256 * 2304 + pos; lseq = 2304; }
            u16* vp = VMT + vbase + (size_t)(h * 64 + 32 * mi + 4 * g) * lseq;
#pragma unroll
            for (int i = 0; i < 16; ++i)
              vp[(size_t)(8 * (i >> 2) + (i & 3)) * lseq] = (u16)(pk2(acc[mi][ni][i], 0.f) & 0xffffu);
          }
        }
    } else {
      const int j = task - N_G2 - N_G3, chunk = j >> 2, gg = j & 3;
      const u16* WS = (const u16*)(p.ws + OFF_GWS) + (size_t)(l * 4 + gg) * 128 * 128;
      const u16* VGT = (const u16*)(p.ws + OFF_VGT) + (size_t)(chunk * 4 + gg) * 64 * 128;
      const u16* UC = (const u16*)(p.ws + OFF_UC);
      u16* MIXIN = (u16*)(p.ws + OFF_MIXIN);
      f32x16 acc[2];
#pragma unroll
      for (int i = 0; i < 16; ++i) { acc[0][i] = 0.f; acc[1][i] = 0.f; }
      const int pp = 32 * w + r;
#pragma unroll
      for (int ks = 0; ks < 8; ++ks) {
        bf16x8 b = *(const bf16x8*)(WS + (size_t)pp * 128 + ks * 16 + 8 * g);
#pragma unroll
        for (int mt = 0; mt < 2; ++mt) {
          bf16x8 a = *(const bf16x8*)(VGT + (size_t)(32 * mt + r) * 128 + ks * 16 + 8 * g);
          acc[mt] = MFMA32(a, b, acc[mt]);
        }
      }
      const float bs = p.gb[(size_t)(l * 4 + gg) * 128 + pp];
      const int t = chunk * 128 + pp;
#pragma unroll
      for (int mt = 0; mt < 2; ++mt)
#pragma unroll
        for (int i = 0; i < 4; ++i) {
          const int d = 32 * mt + 8 * i + 4 * g;
          u32x2 u = *(const u32x2*)(UC + (size_t)t * 256 + gg * 64 + d);
          float o0 = bflo(u[0]) * (acc[mt][4 * i] + bs), o1 = bfhi(u[0]) * (acc[mt][4 * i + 1] + bs);
          float o2 = bflo(u[1]) * (acc[mt][4 * i + 2] + bs), o3 = bfhi(u[1]) * (acc[mt][4 * i + 3] + bs);
          u32x2 o = {pk2(o0, o1), pk2(o2, o3)};
          *(u32x2*)(MIXIN + (size_t)t * HP + 768 + gg * 64 + d) = o;
        }
    }
  }
}

template <int DK>
DI void attn_item(const u16* __restrict__ Q, int ldq, const u16* __restrict__ Kp, int ldk, const u16* __restrict__ VT, int L,
                  u16* __restrict__ O, char* smem) {
  constexpr int KS = DK / 16, KROW = (DK + 8) * 2, KCH = DK / 8, NKC = 64 * KCH / 256;
  const int tid = tid_opaque(), lane = tid & 63, w = tid >> 6, r = lane & 31, g = lane >> 5;
  char* Ks = smem; char* Vs = smem + 64 * KROW;
  bf16x8 qf[KS];
  {
    const u16* qrow = Q + (size_t)(32 * w + r) * ldq + 8 * g;
#pragma unroll
    for (int ks = 0; ks < KS; ++ks) qf[ks] = *(const bf16x8*)(qrow + 16 * ks);
  }
  f32x16 o[2];
#pragma unroll
  for (int i = 0; i < 16; ++i) { o[0][i] = 0.f; o[1][i] = 0.f; }
  float m = -1e30f, lsum = 0.f;
  u32x4 kreg[NKC], vreg[2];
#pragma unroll
  for (int i = 0; i < NKC; ++i) { int id = tid + 256 * i, row = id / KCH, c = id % KCH; kreg[i] = *(const u32x4*)(Kp + (size_t)row * ldk + c * 8); }
#pragma unroll
  for (int i = 0; i < 2; ++i) { int id = tid + 256 * i, row = id >> 3, c = id & 7; vreg[i] = *(const u32x4*)(VT + (size_t)row * L + c * 8); }
  for (int key0 = 0; key0 < L; key0 += 64) {
    __syncthreads();
#pragma unroll
    for (int i = 0; i < NKC; ++i) { int id = tid + 256 * i, row = id / KCH, c = id % KCH; *(u32x4*)(Ks + row * KROW + c * 16) = kreg[i]; }
#pragma unroll
    for (int i = 0; i < 2; ++i) { int id = tid + 256 * i, row = id >> 3, c = id & 7; *(u32x4*)(Vs + row * 144 + c * 16) = vreg[i]; }
    __syncthreads();
    if (key0 + 64 < L) {
      const int kn = key0 + 64;
#pragma unroll
      for (int i = 0; i < NKC; ++i) { int id = tid + 256 * i, row = id / KCH, c = id % KCH; kreg[i] = *(const u32x4*)(Kp + (size_t)(kn + row) * ldk + c * 8); }
#pragma unroll
      for (int i = 0; i < 2; ++i) { int id = tid + 256 * i, row = id >> 3, c = id & 7; vreg[i] = *(const u32x4*)(VT + (size_t)row * L + kn + c * 8); }
    }
    __builtin_amdgcn_s_setprio(2);
    f32x16 s[2];
#pragma unroll
    for (int i = 0; i < 16; ++i) { s[0][i] = 0.f; s[1][i] = 0.f; }
#pragma unroll
    for (int ks = 0; ks < KS; ++ks)
#pragma unroll
      for (int mt = 0; mt < 2; ++mt) {
        bf16x8 a = *(const bf16x8*)(Ks + (32 * mt + r) * KROW + (16 * ks + 8 * g) * 2);
        s[mt] = MFMA32(a, qf[ks], s[mt]);
      }
    float mx = s[0][0];
#pragma unroll
    for (int i = 0; i < 16; ++i) { mx = fmaxf(mx, s[0][i]); mx = fmaxf(mx, s[1][i]); }
    mx = fmaxf(mx, __shfl_xor(mx, 32));
    const float mnew = fmaxf(m, mx);
    const float alpha = __builtin_amdgcn_exp2f(m - mnew);
    m = mnew;
    float ps = 0.f;
#pragma unroll
    for (int mt = 0; mt < 2; ++mt)
#pragma unroll
      for (int i = 0; i < 16; ++i) { float e = __builtin_amdgcn_exp2f(s[mt][i] - mnew); s[mt][i] = e; ps += e; }
    lsum = lsum * alpha + ps;
#pragma unroll
    for (int i = 0; i < 16; ++i) { o[0][i] *= alpha; o[1][i] *= alpha; }
#pragma unroll
    for (int mt = 0; mt < 2; ++mt)
#pragma unroll
      for (int ip = 0; ip < 2; ++ip) {
        u32x4 pb = {pk2(s[mt][8 * ip], s[mt][8 * ip + 1]), pk2(s[mt][8 * ip + 2], s[mt][8 * ip + 3]),
                    pk2(s[mt][8 * ip + 4], s[mt][8 * ip + 5]), pk2(s[mt][8 * ip + 6], s[mt][8 * ip + 7])};
        bf16x8 pbv = __builtin_bit_cast(bf16x8, pb);
#pragma unroll
        for (int dt = 0; dt < 2; ++dt) {
          const char* vrow = Vs + (32 * dt + r) * 144 + (32 * mt + 16 * ip + 4 * g) * 2;
          u32x2 lo = *(const u32x2*)(vrow), hi = *(const u32x2*)(vrow + 16);
          u32x4 av = {lo[0], lo[1], hi[0], hi[1]};
          o[dt] = MFMA32(__builtin_bit_cast(bf16x8, av), pbv, o[dt]);
        }
      }
    __builtin_amdgcn_s_setprio(0);
  }
  lsum += __shfl_xor(lsum, 32);
  const float inv = 1.f / lsum;
  u16* orow = O + (size_t)(32 * w + r) * HP;
#pragma unroll
  for (int dt = 0; dt < 2; ++dt)
#pragma unroll
    for (int i = 0; i < 4; ++i) {
      u32x2 ov = {pk2(o[dt][4 * i] * inv, o[dt][4 * i + 1] * inv), pk2(o[dt][4 * i + 2] * inv, o[dt][4 * i + 3] * inv)};
      *(u32x2*)(orow + 32 * dt + 8 * i + 4 * g) = ov;
    }
}

DI void attn_phase(const Params& p, char* smem) {
  const u16* QA = (const u16*)(p.ws + OFF_QA); const u16* QM = (const u16*)(p.ws + OFF_QM);
  const u16* KA = (const u16*)(p.ws + OFF_KA); const u16* KM = (const u16*)(p.ws + OFF_KM);
  const u16* VAT = (const u16*)(p.ws + OFF_VAT); const u16* VMT = (const u16*)(p.ws + OFF_VMT);
  u16* MIXIN = (u16*)(p.ws + OFF_MIXIN);
  const int xq = blockIdx.x & 7, qq = blockIdx.x >> 3, nbx = (int)((gridDim.x - xq + 7) >> 3);
  for (int i = qq; i < 288; i += nbx) {
    if (i < 64) {
      const int bl = xq, h = i >> 4, qb = i & 15;
      const int t0 = TC + bl * 2048 + qb * 128, kr0 = TC + bl * 2304;
      attn_item<96>(QM + (size_t)t0 * 384 + h * 96, 384, KM + (size_t)kr0 * 384 + h * 96, 384,
                    VMT + (size_t)32 * 256 * 256 + (size_t)(bl * 256 + h * 64) * 2304, 2304, MIXIN + (size_t)t0 * HP + 512 + h * 64, smem);
    } else if (i < 192) {
      const int j = i - 64, bl = xq, hq = j >> 4, qb = j & 15, kvh = hq >> 2;
      const int t0 = TC + bl * 2048 + qb * 128, kr0 = TC + bl * 2304;
      attn_item<64>(QA + (size_t)t0 * 512 + hq * 64, 512, KA + (size_t)kr0 * 128 + kvh * 64, 128,
                    VAT + (size_t)32 * 128 * 256 + (size_t)(bl * 128 + kvh * 64) * 2304, 2304, MIXIN + (size_t)t0 * HP + hq * 64, smem);
    } else {
      const int j = i - 192, b = xq * 4 + j / 24, rem = j % 24;
      const int kr0 = b * 256;
      if (rem < 8) {
        const int h = rem >> 1, qb = rem & 1, t0 = b * 256 + qb * 128;
        attn_item<96>(QM + (size_t)t0 * 384 + h * 96, 384, KM + (size_t)kr0 * 384 + h * 96, 384,
                      VMT + (size_t)(b * 256 + h * 64) * 256, 256, MIXIN + (size_t)t0 * HP + 512 + h * 64, smem);
      } else {
        const int rr = rem - 8, hq = rr >> 1, qb = rr & 1, kvh = hq >> 2, t0 = b * 256 + qb * 128;
        attn_item<64>(QA + (size_t)t0 * 512 + hq * 64, 512, KA + (size_t)kr0 * 128 + kvh * 64, 128,
                      VAT + (size_t)(b * 128 + kvh * 64) * 256, 256, MIXIN + (size_t)t0 * HP + hq * 64, smem);
      }
    }
  }
}

DI void g4_phase(const Params& p, int l, char* smem) {
  const u16* W = (const u16*)(p.ws + OFF_WO) + (size_t)l * 1024 * WP;
  const u16* X = (const u16*)(p.ws + OFF_MIXIN);
  float* C = (float*)(p.ws + OFF_MIXOUT);
  const int xq = blockIdx.x & 7, qq = blockIdx.x >> 3, nbx = (int)((gridDim.x - xq + 7) >> 3);
  for (int i = qq; i < 24 * 8; i += nbx) {
    const int tt = (i >> 3) * 8 + xq, nt = i & 7;
    f32x16 acc[2][2];
    gemm_mainloop(W + (size_t)nt * 128 * WP, WP, X + (size_t)tt * 128 * HP, HP, 1024, smem, acc);
    epi_store_f32(acc, C, MP, nt * 128, tt * 128);
  }
}

DI void r2_phase(const Params& p, int l) {
  const int lane = tid_opaque() & 63, w = tid_opaque() >> 6;
  float* MIX = (float*)(p.ws + OFF_MIXOUT);
  u16* H2 = (u16*)(p.ws + OFF_H2);
  const float* lg = p.ln1g + l * 1024; const float* lb = p.ln1b + l * 1024;
  for (int t = blockIdx.x * 4 + w; t < T; t += gridDim.x * 4) {
    const float* xr = (l == 0) ? xin_row(p, t) : (p.out + (size_t)t * 1024);
    const float* m = (const float*)(p.ws + OFF_MOD) + (size_t)(l * 9 + tok_modrow(t)) * 6144;
    float y[16];
#pragma unroll
    for (int i = 0; i < 4; ++i) {
      int c = 4 * (lane + 64 * i);
      f32x4 xv = *(const f32x4*)(xr + c), mv = *(const f32x4*)(MIX + (size_t)t * MP + c), g1 = *(const f32x4*)(m + 2048 + c);
#pragma unroll
      for (int e = 0; e < 4; ++e) y[4 * i + e] = ALPHA * xv[e] + g1[e] * mv[e];
    }
    float mu, rstd; ln_stats16(y, mu, rstd);
#pragma unroll
    for (int i = 0; i < 4; ++i) {
      int c = 4 * (lane + 64 * i);
      f32x4 gv = *(const f32x4*)(lg + c), bv = *(const f32x4*)(lb + c);
      f32x4 o;
#pragma unroll
      for (int e = 0; e < 4; ++e) { y[4 * i + e] = (y[4 * i + e] - mu) * rstd * gv[e] + bv[e]; o[e] = y[4 * i + e]; }
      *(f32x4*)(MIX + (size_t)t * MP + c) = o;
    }
    ln_stats16(y, mu, rstd);
#pragma unroll
    for (int i = 0; i < 4; ++i) {
      int c = 4 * (lane + 64 * i);
      f32x4 sh = *(const f32x4*)(m + 3072 + c), sc = *(const f32x4*)(m + 4096 + c);
      float h[4];
#pragma unroll
      for (int e = 0; e < 4; ++e) h[e] = (y[4 * i + e] - mu) * rstd * (1.f + sc[e]) + sh[e];
      u32x2 o = {pk2(h[0], h[1]), pk2(h[2], h[3])};
      *(u32x2*)(H2 + (size_t)t * HP + c) = o;
    }
  }
}

DI void ce_desc(unsigned& a, unsigned& b) { unsigned mx = a > b ? a : b, mn = a > b ? b : a; a = mx; b = mn; }
DI void sort16_desc(unsigned (&a)[16]) {
#pragma unroll
  for (int k = 2; k <= 16; k <<= 1) {
#pragma unroll
    for (int j = k >> 1; j > 0; j >>= 1) {
#pragma unroll
      for (int i = 0; i < 16; ++i) {
        const int l2 = i ^ j;
        if (l2 > i) { if ((i & k) == 0) ce_desc(a[i], a[l2]); else ce_desc(a[l2], a[i]); }
      }
    }
  }
}
DI void merge16_desc(unsigned (&a)[16]) {
#pragma unroll
  for (int j = 8; j > 0; j >>= 1) {
#pragma unroll
    for (int i = 0; i < 16; ++i) { const int l2 = i ^ j; if (l2 > i) ce_desc(a[i], a[l2]); }
  }
}
DI void top16_merge(unsigned (&a)[16], const unsigned (&b)[16]) {
#pragma unroll
  for (int i = 0; i < 16; ++i) a[i] = a[i] > b[15 - i] ? a[i] : b[15 - i];
  merge16_desc(a);
}
DI unsigned score_key(float f, int idx) {
  unsigned u = __float_as_uint(f);
  u ^= (unsigned)((int)u >> 31) | 0x80000000u;
  return (u & ~127u) | (unsigned)(127 - idx);
}
DI float key_val(unsigned k) {
  unsigned u = k & ~127u;
  u = (u & 0x80000000u) ? (u ^ 0x80000000u) : ~u;
  return __uint_as_float(u);
}

DI void g5_phase(const Params& p, int l, char* smem) {
  const int tid = tid_opaque(), lane = tid & 63, w = tid >> 6, wm = w >> 1, wn = w & 1, r = lane & 31, g = lane >> 5;
  const u16* W = (const u16*)(p.ws + OFF_PWQ) + (size_t)l * 2048 * WP;
  const u16* X = (const u16*)(p.ws + OFF_H2);
  unsigned* TOPK = (unsigned*)(p.ws + OFF_TOPK);
  char* Qs = smem;
  const int xq = blockIdx.x & 7, qq = blockIdx.x >> 3, nbx = (int)((gridDim.x - xq + 7) >> 3);
  for (int i = qq; i < 24 * 16; i += nbx) {
    const int tt = (i >> 4) * 8 + xq, nt = i & 15;
    f32x16 acc[2][2];
    gemm_mainloop(W + (size_t)nt * 128 * WP, WP, X + (size_t)tt * 128 * HP, HP, 1024, smem, acc);
    __syncthreads();
#pragma unroll
    for (int mi = 0; mi < 2; ++mi)
#pragma unroll
      for (int ni = 0; ni < 2; ++ni)
#pragma unroll
        for (int i = 0; i < 4; ++i) {
          u32x2 o = {pk2(acc[mi][ni][4 * i], acc[mi][ni][4 * i + 1]), pk2(acc[mi][ni][4 * i + 2], acc[mi][ni][4 * i + 3])};
          *(u32x2*)(Qs + (64 * wn + 32 * ni + r) * 272 + (64 * wm + 32 * mi + 8 * i + 4 * g) * 2) = o;
        }
    __syncthreads();
    const int h = nt >> 1, half = nt & 1;
    const u16* PK = (const u16*)(p.ws + OFF_PK) + (size_t)(l * 2 + half) * 16384;
    unsigned z[16], y[16];
#pragma unroll
    for (int i = 0; i < 16; ++i) z[i] = 0u;
    bf16x8 qfr[8];
#pragma unroll
    for (int ks = 0; ks < 8; ++ks) qfr[ks] = *(const bf16x8*)(Qs + (32 * w + r) * 272 + (16 * ks + 8 * g) * 2);
#pragma unroll 1
    for (int mt = 0; mt < 4; ++mt) {
      f32x16 sc;
#pragma unroll
      for (int i = 0; i < 16; ++i) sc[i] = 0.f;
#pragma unroll
      for (int ks = 0; ks < 8; ++ks) {
        bf16x8 a = *(const bf16x8*)(PK + (size_t)(32 * mt + r) * 128 + 16 * ks + 8 * g);
        sc = MFMA32(a, qfr[ks], sc);
      }
#pragma unroll
      for (int i = 0; i < 16; ++i) y[i] = score_key(sc[i], 32 * mt + 8 * (i >> 2) + 4 * g + (i & 3));
      sort16_desc(y);
      top16_merge(z, y);
    }
#pragma unroll
    for (int i = 0; i < 16; ++i) y[15 - i] = (unsigned)__shfl_xor((int)z[i], 32);
#pragma unroll
    for (int i = 0; i < 16; ++i) z[i] = z[i] > y[i] ? z[i] : y[i];
    merge16_desc(z);
    if (g == 0) {
      const int t = tt * 128 + 32 * w + r;
      unsigned* dst = TOPK + ((size_t)(t * 8 + h) * 2 + half) * 16;
#pragma unroll
      for (int i = 0; i < 4; ++i) { u32x4 o = {z[4 * i], z[4 * i + 1], z[4 * i + 2], z[4 * i + 3]}; *(u32x4*)(dst + 4 * i) = o; }
    }
  }
}

DI constexpr int sel_pi(int m) { return m < 16 ? 0 : m < 24 ? 1 : m < 29 ? 2 : m < 33 ? 3 : m < 36 ? 4 : m < 38 ? 5 : m < 40 ? 6 : m < 42 ? 7 : m < 50 ? m - 34 : 0; }
DI constexpr int sel_pj(int m) { return m < 16 ? m : m < 24 ? m - 16 : m < 29 ? m - 24 : m < 33 ? m - 29 : m < 36 ? m - 33 : m < 38 ? m - 36 : m < 40 ? m - 38 : m < 42 ? m - 40 : 0; }
DI unsigned sum_key(float f, int m) {
  unsigned u = __float_as_uint(f);
  u ^= (unsigned)((int)u >> 31) | 0x80000000u;
  return (u & ~63u) | (unsigned)(63 - m);
}
DI float sum_key_val(unsigned k) {
  unsigned u = k & ~63u;
  u = (u & 0x80000000u) ? (u ^ 0x80000000u) : ~u;
  return __uint_as_float(u);
}
DI void sel_phase(const Params& p, int l, char* smem) {
  const int tid = tid_opaque();
  unsigned char* s_tab = (unsigned char*)smem;
  unsigned char* s_ii = (unsigned char*)smem + 256 + tid * 32;
  __syncthreads();
  if (tid < 64) { s_tab[2 * tid] = (unsigned char)sel_pi(tid); s_tab[2 * tid + 1] = (unsigned char)sel_pj(tid); }
  __syncthreads();
  const unsigned* TOPK = (const unsigned*)(p.ws + OFF_TOPK);
  const float* SU = (const float*)(p.ws + OFF_SU) + l * 16384;
  const float* SV = (const float*)(p.ws + OFF_SV) + l * 16384;
  int* SIDX = (int*)(p.ws + OFF_SIDX); float* SW = (float*)(p.ws + OFF_SW); float* SSU = (float*)(p.ws + OFF_SSU);
  for (int item = blockIdx.x * 256 + tid; item < T * 8; item += gridDim.x * 256) {
    const unsigned* tk = TOPK + (size_t)item * 32;
    float v1[16], v2[16];
#pragma unroll
    for (int q = 0; q < 4; ++q) {
      const u32x4 a = *(const u32x4*)(tk + 4 * q), b = *(const u32x4*)(tk + 16 + 4 * q);
#pragma unroll
      for (int e = 0; e < 4; ++e) {
        v1[4 * q + e] = key_val(a[e]); s_ii[4 * q + e] = (unsigned char)(127u - (a[e] & 127u));
        v2[4 * q + e] = key_val(b[e]); s_ii[16 + 4 * q + e] = (unsigned char)(127u - (b[e] & 127u));
      }
    }
    unsigned z[16], y[16];
#pragma unroll
    for (int i = 0; i < 16; ++i) z[i] = sum_key(v1[sel_pi(i)] + v2[sel_pj(i)], i);
    sort16_desc(z);
#pragma unroll
    for (int gq = 1; gq < 4; ++gq) {
#pragma unroll
      for (int i = 0; i < 16; ++i) { const int m = 16 * gq + i; y[i] = (m < 50) ? sum_key(v1[sel_pi(m)] + v2[sel_pj(m)], m) : 0u; }
      sort16_desc(y);
      top16_merge(z, y);
    }
    const float mx = sum_key_val(z[0]);
    float ev[16], sum = 0.f;
#pragma unroll
    for (int r = 0; r < 16; ++r) { ev[r] = __expf(sum_key_val(z[r]) - mx); sum += ev[r]; }
    const float inv = 1.f / sum;
    int id[16];
#pragma unroll
    for (int r = 0; r < 16; ++r) {
      const int m = 63 - (int)(z[r] & 63u);
      const int ci = s_tab[2 * m], cj = s_tab[2 * m + 1];
      id[r] = (int)s_ii[ci] * 128 + (int)s_ii[16 + cj];
    }
#pragma unroll
    for (int q = 0; q < 4; ++q) {
      u32x4 oi; f32x4 ow, os;
#pragma unroll
      for (int e = 0; e < 4; ++e) { const int r = 4 * q + e; oi[e] = (unsigned)id[r]; ow[e] = ev[r] * inv * SV[id[r]]; os[e] = SU[id[r]]; }
      *(u32x4*)(SIDX + (size_t)item * 16 + 4 * q) = oi;
      *(f32x4*)(SW + (size_t)item * 16 + 4 * q) = ow;
      *(f32x4*)(SSU + (size_t)item * 16 + 4 * q) = os;
    }
  }
}

#ifndef VRING
#define VRING 16
#endif
#define MFMA8(a, b, c) __builtin_amdgcn_mfma_f32_16x16x32_fp8_fp8((a), (b), (c), 0, 0, 0)
DI long mk64(unsigned lo, unsigned hi) { return (long)(((unsigned long)hi << 32) | (unsigned long)lo); }
DI void e_phase(const Params& p, int l, char* smem) {
  const int tid = tid_opaque(), lane = tid & 63, w = tid >> 6;
  char* xh = smem + w * 2048;
  char* xl = xh + 1024;
  int* s_idx = (int*)(smem + 8192) + w * 128;
  float* s_w = (float*)(smem + 8192 + 2048) + w * 128;
  float* s_su = (float*)(smem + 8192 + 4096) + w * 128;
  const u16* H2 = (const u16*)(p.ws + OFF_H2);
  const int* SIDX = (const int*)(p.ws + OFF_SIDX); const float* SW = (const float*)(p.ws + OFF_SW); const float* SSU = (const float*)(p.ws + OFF_SSU);
  const unsigned char* PU = (const unsigned char*)(p.ws + OFF_PU) + (size_t)l * 16384 * 512;
  const unsigned char* PV = (const unsigned char*)(p.ws + OFF_PV) + (size_t)l * 16384 * 512;
  const float* SU = (const float*)(p.ws + OFF_SU) + l * 16384;
  const float* SV = (const float*)(p.ws + OFF_SV) + l * 16384;
  const float* X1 = (const float*)(p.ws + OFF_MIXOUT);
  u16* H = (u16*)(p.ws + OFF_H);
  const float* lg = p.ln2g + l * 1024; const float* lb = p.ln2b + l * 1024;
  int ci, cj;
  {
    const int c = lane;
    if (c < 16) { ci = 0; cj = c; } else if (c < 24) { ci = 1; cj = c - 16; } else if (c < 29) { ci = 2; cj = c - 24; }
    else if (c < 33) { ci = 3; cj = c - 29; } else if (c < 36) { ci = 4; cj = c - 33; } else if (c < 38) { ci = 5; cj = c - 36; }
    else if (c < 40) { ci = 6; cj = c - 38; } else if (c < 42) { ci = 7; cj = c - 40; } else if (c < 50) { ci = c - 34; cj = 0; }
    else { ci = 0; cj = 0; }
  }
  const bool cand_ok = lane < 50;
  const int r16 = lane & 15, kq = lane >> 4;
  for (int t = blockIdx.x * 4 + w; t < T; t += gridDim.x * 4) {
    const int l32 = lane & 31, half = lane >> 5;
    f32x2_t xv[16];
    {
      const u16* hp = H2 + (size_t)t * HP + 32 * l32;
#pragma unroll
      for (int q = 0; q < 4; ++q) {
        const u32x4 a = *(const u32x4*)(hp + 8 * q);
#pragma unroll
        for (int i = 0; i < 4; ++i) { xv[4 * q + i][0] = bflo(a[i]); xv[4 * q + i][1] = bfhi(a[i]); }
      }
    }
#pragma unroll
    for (int j = 0; j < 2; ++j) {
      const int e = lane + 64 * j;
      s_idx[e] = SIDX[(size_t)t * 128 + e]; s_w[e] = SW[(size_t)t * 128 + e]; s_su[e] = SSU[(size_t)t * 128 + e];
    }
    __builtin_amdgcn_fence(__ATOMIC_SEQ_CST, "wavefront");
    __builtin_amdgcn_wave_barrier();
    const unsigned rlo = 16u * (unsigned)l32;
    {
      const bool b4 = (lane & 16) != 0, b3 = (lane & 8) != 0, b2 = (lane & 4) != 0;
      const int eloc = 2 * ((b4 ? 4 : 0) + (b3 ? 2 : 0) + (b2 ? 1 : 0)) + half;
      u32x4 ur[8];
#pragma unroll
      for (int pq = 0; pq < 8; ++pq) ur[pq] = *(const u32x4*)(PU + ((unsigned)s_idx[2 * pq + half] * 512u + rlo));
#pragma unroll 1
      for (int g = 0; g < 8; ++g) {
        float part[8];
        const int gn = (g + 1) & 7;
#pragma unroll
        for (int pq = 0; pq < 8; ++pq) {
          const u32x4 v = ur[pq];
          if (g < 7) ur[pq] = *(const u32x4*)(PU + ((unsigned)s_idx[gn * 16 + 2 * pq + half] * 512u + rlo));
          f32x2_t accv = {0.f, 0.f};
#pragma unroll
          for (int q = 0; q < 4; ++q) {
            f32x2_t d0 = __builtin_amdgcn_cvt_scalef32_pk_f32_fp4(v[q], 1.0f, 0), d1 = __builtin_amdgcn_cvt_scalef32_pk_f32_fp4(v[q], 1.0f, 1);
            f32x2_t d2 = __builtin_amdgcn_cvt_scalef32_pk_f32_fp4(v[q], 1.0f, 2), d3 = __builtin_amdgcn_cvt_scalef32_pk_f32_fp4(v[q], 1.0f, 3);
            accv += xv[4 * q] * d0; accv += xv[4 * q + 1] * d1; accv += xv[4 * q + 2] * d2; accv += xv[4 * q + 3] * d3;
          }
          part[pq] = accv[0] + accv[1];
          asm volatile("" : "+v"(part[pq]));
        }
        float p4[4], p2[2];
#pragma unroll
        for (int i = 0; i < 4; ++i) {
          const auto sw = __builtin_amdgcn_permlane16_swap(__float_as_uint(part[i]), __float_as_uint(part[4 + i]), false, false);
          p4[i] = __uint_as_float(sw[0]) + __uint_as_float(sw[1]);
        }
#pragma unroll
        for (int i = 0; i < 2; ++i) { const float mine = b3 ? p4[2 + i] : p4[i], oth = b3 ? p4[i] : p4[2 + i]; p2[i] = mine + __shfl_xor(oth, 8); }
        float a1 = (b2 ? p2[1] : p2[0]) + __shfl_xor(b2 ? p2[0] : p2[1], 4);
        a1 += __shfl_xor(a1, 2); a1 += __shfl_xor(a1, 1);
        const int e = g * 16 + eloc;
        const float wvv = s_w[e] * gelu_tanh(s_su[e] * a1);
        __builtin_amdgcn_fence(__ATOMIC_SEQ_CST, "wavefront");
        __builtin_amdgcn_wave_barrier();
        if ((lane & 3) == 0) s_w[e] = wvv;
      }
    }
    __builtin_amdgcn_fence(__ATOMIC_SEQ_CST, "wavefront");
    __builtin_amdgcn_wave_barrier();
    float ff[16];
    {
      f32x2_t fv[16];
#pragma unroll
      for (int i = 0; i < 16; ++i) { fv[i][0] = 0.f; fv[i][1] = 0.f; }
      u32x4 vr[8];
#pragma unroll
      for (int j = 0; j < 8; ++j) vr[j] = *(const u32x4*)(PV + ((unsigned)s_idx[2 * j + half] * 512u + rlo));
#pragma unroll 1
      for (int p0 = 0; p0 < 64; p0 += 8) {
        const int pn = (p0 + 8) & 63;
#pragma unroll
        for (int j = 0; j < 8; ++j) {
          const u32x4 v = vr[j];
          vr[j] = *(const u32x4*)(PV + ((unsigned)s_idx[2 * (pn + j) + half] * 512u + rlo));
          const float we = s_w[2 * (p0 + j) + half];
          const f32x2_t we2 = {we, we};
#pragma unroll
          for (int q = 0; q < 4; ++q) {
            f32x2_t d0 = __builtin_amdgcn_cvt_scalef32_pk_f32_fp4(v[q], 1.0f, 0), d1 = __builtin_amdgcn_cvt_scalef32_pk_f32_fp4(v[q], 1.0f, 1);
            f32x2_t d2 = __builtin_amdgcn_cvt_scalef32_pk_f32_fp4(v[q], 1.0f, 2), d3 = __builtin_amdgcn_cvt_scalef32_pk_f32_fp4(v[q], 1.0f, 3);
            fv[4 * q] += we2 * d0; fv[4 * q + 1] += we2 * d1; fv[4 * q + 2] += we2 * d2; fv[4 * q + 3] += we2 * d3;
          }
          asm volatile("" : "+v"(fv[0]), "+v"(fv[1]), "+v"(fv[2]), "+v"(fv[3]), "+v"(fv[4]), "+v"(fv[5]), "+v"(fv[6]), "+v"(fv[7]),
                            "+v"(fv[8]), "+v"(fv[9]), "+v"(fv[10]), "+v"(fv[11]), "+v"(fv[12]), "+v"(fv[13]), "+v"(fv[14]), "+v"(fv[15]));
        }
      }
#pragma unroll
      for (int i = 0; i < 8; ++i) {
        const auto s0 = __builtin_amdgcn_permlane32_swap(__float_as_uint(fv[i][0]), __float_as_uint(fv[8 + i][0]), false, false);
        const auto s1 = __builtin_amdgcn_permlane32_swap(__float_as_uint(fv[i][1]), __float_as_uint(fv[8 + i][1]), false, false);
        ff[2 * i] = __uint_as_float(s0[0]) + __uint_as_float(s0[1]);
        ff[2 * i + 1] = __uint_as_float(s1[0]) + __uint_as_float(s1[1]);
      }
    }
    const int cb = 32 * l32 + 16 * half;
    __builtin_amdgcn_fence(__ATOMIC_SEQ_CST, "wavefront");
    __builtin_amdgcn_wave_barrier();
    const float* m = (const float*)(p.ws + OFF_MOD) + (size_t)(l * 9 + tok_modrow(t)) * 6144;
    float y[16];
#pragma unroll
    for (int q = 0; q < 4; ++q) {
      const int c = cb + 4 * q;
      f32x4 xv = *(const f32x4*)(X1 + (size_t)t * MP + c), g2 = *(const f32x4*)(m + 5120 + c);
#pragma unroll
      for (int e = 0; e < 4; ++e) y[4 * q + e] = ALPHA * xv[e] + g2[e] * ff[4 * q + e];
    }
    float mu, rstd; ln_stats16(y, mu, rstd);
#pragma unroll
    for (int q = 0; q < 4; ++q) {
      const int c = cb + 4 * q;
      f32x4 gv = *(const f32x4*)(lg + c), bv = *(const f32x4*)(lb + c), o;
#pragma unroll
      for (int e = 0; e < 4; ++e) { float v = (y[4 * q + e] - mu) * rstd * gv[e] + bv[e]; y[4 * q + e] = v; o[e] = v; }
      *(f32x4*)(p.out + (size_t)t * 1024 + c) = o;
    }
    if (l == 0) {
      const float* m1 = (const float*)(p.ws + OFF_MOD) + (size_t)(9 + tok_modrow(t)) * 6144;
      ln_stats16(y, mu, rstd);
#pragma unroll
      for (int hh = 0; hh < 2; ++hh) {
        const int c = cb + 8 * hh;
        f32x4 sh0 = *(const f32x4*)(m1 + c), sh1 = *(const f32x4*)(m1 + c + 4), sc0 = *(const f32x4*)(m1 + 1024 + c), sc1 = *(const f32x4*)(m1 + 1024 + c + 4);
        float hv[8];
#pragma unroll
        for (int e = 0; e < 4; ++e) {
          hv[e] = (y[8 * hh + e] - mu) * rstd * (1.f + sc0[e]) + sh0[e];
          hv[4 + e] = (y[8 * hh + 4 + e] - mu) * rstd * (1.f + sc1[e]) + sh1[e];
        }
        u32x4 o = {pk2(hv[0], hv[1]), pk2(hv[2], hv[3]), pk2(hv[4], hv[5]), pk2(hv[6], hv[7])};
        *(u32x4*)(H + (size_t)t * HP + c) = o;
      }
    }
  }
}

#define XB_TMO      128
#define XB_XCNT(j)  (256  + 64 * (j))
#define XB_XSUB(j)  (1280 + 64 * (j))
#define XB_XGEN(j)  (2304 + 64 * (j))
#define XB_TOP      3328
#define XB_TOPGEN   3392
#define XCD_BAR_WORDS 3456
#define XB_SPIN_CAP (1u << 18)
#define LAS __attribute__((address_space(3)))
__device__ __forceinline__ unsigned xb_ld(unsigned* p)              { return __hip_atomic_load(p, __ATOMIC_RELAXED, __HIP_MEMORY_SCOPE_AGENT); }
__device__ __forceinline__ unsigned xb_add(unsigned* p, unsigned v) { return __hip_atomic_fetch_add(p, v, __ATOMIC_RELAXED, __HIP_MEMORY_SCOPE_AGENT); }
__device__ __forceinline__ unsigned xb_xcc_id() { return (unsigned)__builtin_amdgcn_s_getreg((3 << 11) | 20) & 0xFu; }
#define XB_SPIN(cond, bar) do { unsigned _sp = 0; while (cond) { __builtin_amdgcn_s_sleep(1); \
    if ((++_sp & 255u) == 0u) { if (xb_ld(&(bar)[XB_TMO])) break; if (_sp > XB_SPIN_CAP) { atomicAdd(&(bar)[XB_TMO], 1u); break; } } } } while (0)
struct XcdBarrier { unsigned* bar; unsigned x; volatile LAS unsigned* st; };
__device__ __forceinline__ XcdBarrier xcd_barrier_post(unsigned* bar, volatile LAS unsigned* st) {
    XcdBarrier b; b.bar = bar; b.x = xb_xcc_id(); b.st = st;
    if (threadIdx.x == 0) (void)xb_add(&bar[XB_XCNT(b.x)], 1u);
    return b;
}
__device__ __forceinline__ void xcd_barrier_complete(unsigned* bar, unsigned x, unsigned& nloc, unsigned& nx) {
    const unsigned G = gridDim.x * gridDim.y * gridDim.z;
    unsigned sum, cnt, mine, sp = 0u;
    for (;;) {
        sum = 0u; cnt = 0u; mine = 0u;
#pragma unroll
        for (unsigned j = 0; j < 16; ++j) { const unsigned c = xb_ld(&bar[XB_XCNT(j)]); sum += c; cnt += (c > 0u) ? 1u : 0u; mine = (j == x) ? c : mine; }
        if (sum == G) break;
        __builtin_amdgcn_s_sleep(1);
        if ((++sp & 255u) == 0u) { if (xb_ld(&bar[XB_TMO])) break; if (sp > XB_SPIN_CAP) { atomicAdd(&bar[XB_TMO], 1u); break; } }
    }
    nloc = mine > 0u ? mine : 1u; nx = cnt > 0u ? cnt : 1u;
}
__device__ __forceinline__ void xcd_barrier(const XcdBarrier& b) {
    asm volatile("s_waitcnt vmcnt(0)" ::: "memory");
    __syncthreads();
    if (threadIdx.x == 0) {
        unsigned* bar = b.bar;
        __builtin_amdgcn_s_waitcnt(0);
        unsigned nloc = b.st[0], nx = b.st[1];
        if (nloc == 0u) { xcd_barrier_complete(bar, b.x, nloc, nx); b.st[0] = nloc; b.st[1] = nx; }
        const unsigned old = xb_add(&bar[XB_XSUB(b.x)], 1u);
        const unsigned gen = old / nloc;
        if (old + 1u == (gen + 1u) * nloc) {
            __builtin_amdgcn_fence(__ATOMIC_RELEASE, "agent");
            asm volatile("s_waitcnt vmcnt(0)" ::: "memory");
            const unsigned og = xb_add(&bar[XB_TOP], 1u);
            const unsigned tg = og / nx;
            if (og + 1u == (tg + 1u) * nx) xb_add(&bar[XB_TOPGEN], 1u);
            else XB_SPIN(xb_ld(&bar[XB_TOPGEN]) == tg, bar);
            __builtin_amdgcn_fence(__ATOMIC_ACQUIRE, "agent");
            xb_add(&bar[XB_XGEN(b.x)], 1u);
            asm volatile("s_waitcnt vmcnt(0)" ::: "memory");
        } else {
            XB_SPIN(xb_ld(&bar[XB_XGEN(b.x)]) == gen, bar);
            __builtin_amdgcn_fence(__ATOMIC_ACQUIRE, "agent");
            asm volatile("s_waitcnt vmcnt(0)" ::: "memory");
        }
    }
    __syncthreads();
}

constexpr int NPHASE = 2 + 2 * 9;
#ifndef PH_MASK
#define PH_MASK 2047
#endif
#ifndef PH_TWICE
#define PH_TWICE 0
#endif
__global__ void __launch_bounds__(256, 3) fwd_megakernel(Params p, int ph_lo, int ph_hi) {
  __shared__ __attribute__((aligned(16))) char smem[SMEM_BYTES];
  cg::grid_group grid = cg::this_grid();
  __shared__ uint4 xb_words;
  if (threadIdx.x == 0) xb_words = make_uint4(0u, 0u, 0u, 0u);
  __syncthreads();
  const XcdBarrier xb = xcd_barrier_post((unsigned*)(p.ws + OFF_BAR), (volatile LAS unsigned*)&xb_words);
  if (ph_lo < 0) grid.sync();
#define RUN_PH(ph, mask, call) { const int ph_ = (ph); if (ph_ >= ph_lo && ph_ < ph_hi) { if (ph_ > ph_lo) xcd_barrier(xb); if (PH_MASK & (mask)) { call; } if (PH_TWICE & (mask)) { xcd_barrier(xb); call; } } }
  RUN_PH(0, 1, prep_phase(p, smem));
  RUN_PH(1, 2, s0_phase(p));
  for (int l = 0; l < 2; ++l) {
    const int b = 2 + 9 * l;
    RUN_PH(b + 0, 4, g1_phase(p, l, smem));
    RUN_PH(b + 1, 8, r1_phase(p, l, smem));
    RUN_PH(b + 2, 16, mid_phase(p, l, smem));
    RUN_PH(b + 3, 32, attn_phase(p, smem));
    RUN_PH(b + 4, 64, g4_phase(p, l, smem));
    RUN_PH(b + 5, 128, r2_phase(p, l));
    RUN_PH(b + 6, 256, g5_phase(p, l, smem));
    RUN_PH(b + 7, 1024, sel_phase(p, l, smem));
    RUN_PH(b + 8, 512, e_phase(p, l, smem));
  }
}

#ifndef MULTI_LAUNCH
#define MULTI_LAUNCH 0
#endif

extern "C" void kernel_launch(void* const* d_in, const int* in_sizes, int n_in, void* d_out, int out_size, void* d_ws, size_t ws_size,
                              hipStream_t stream) {
  (void)in_sizes; (void)n_in; (void)out_size;
  if (ws_size < WS_NEED) { fprintf(stderr, "workspace too small: %zu < %zu\n", ws_size, (size_t)WS_NEED); return; }
  Params p{};
  const float** pp = (const float**)&p;
  for (int i = 0; i < 29; ++i) pp[i] = (const float*)d_in[i];
  p.out = (float*)d_out; p.ws = (char*)d_ws;
  static int grid_blocks = 0;
  if (!grid_blocks) {
    int dev = 0, cus = 0, per_cu = 0;
    hipGetDevice(&dev);
    hipDeviceGetAttribute(&cus, hipDeviceAttributeMultiprocessorCount, dev);
    hipOccupancyMaxActiveBlocksPerMultiprocessor(&per_cu, fwd_megakernel, 256, 0);
    if (per_cu < 1) per_cu = 1;
    grid_blocks = cus * per_cu;
  }
  hipMemsetAsync((char*)d_ws + OFF_MOD, 0, SZ_MOD + SZ_BAR, stream);
#if MULTI_LAUNCH
  for (int ph = 0; ph < NPHASE; ++ph) {
    int lo = ph, hi = ph + 1;
    hipLaunchKernelGGL(fwd_megakernel, dim3(grid_blocks), dim3(256), 0, stream, p, lo, hi);
  }
#else
  int lo = 0, hi = NPHASE;
  void* args[] = {&p, &lo, &hi};
  hipError_t e = hipLaunchCooperativeKernel((void*)fwd_megakernel, dim3(grid_blocks), dim3(256), args, 0, stream);
  if (e != hipSuccess) fprintf(stderr, "cooperative launch failed: %s (grid %d)\n", hipGetErrorString(e), grid_blocks);
#endif
}
```

```cpp
#include <hip/hip_runtime.h>
#include <hip/hip_cooperative_groups.h>
#include <cstdio>
#include <cstdint>
namespace cg = cooperative_groups;

typedef unsigned short u16;
typedef __bf16 bf16x2_t __attribute__((ext_vector_type(2)));
typedef float f32x2_t __attribute__((ext_vector_type(2)));
using bf16x8 = __attribute__((ext_vector_type(8))) short;
using f32x16 = __attribute__((ext_vector_type(16))) float;
using f32x4 = __attribute__((ext_vector_type(4))) float;
using u32x4 = __attribute__((ext_vector_type(4))) unsigned;
using u32x2 = __attribute__((ext_vector_type(2))) unsigned;
#define DI __device__ __forceinline__
#define MFMA32(a, b, c) __builtin_amdgcn_mfma_f32_32x32x16_bf16((a), (b), (c), 0, 0, 0)
#define MFMA16(a, b, c) __builtin_amdgcn_mfma_f32_16x16x32_bf16((a), (b), (c), 0, 0, 0)

constexpr int T = 24576, TC = 8192, NK = 26624, PLD = 1792;
constexpr int HP = 1088;
constexpr int WP = 1088;
constexpr int MP = 1056;
constexpr float LOG2E = 1.4426950408889634f;
constexpr float ALPHA = 1.4142135623730951f;
constexpr float EPS = 1e-6f;

struct Params {
  const float* x_prompt; const float* x_sample; const float* cache_k; const float* cache_v; const float* cache_ckv; const float* cache_kr;
  const float* c; const float* c_ctx; const float* w_mod; const float* b_mod; const float* w_in; const float* aqn; const float* akn;
  const float* mqn; const float* mkvn; const float* w_uq; const float* w_ukv; const float* gws; const float* gb; const float* w_o;
  const float* ln1g; const float* ln1b; const float* ln2g; const float* ln2b; const float* pwq; const float* pk1; const float* pk2;
  const float* pu; const float* pv;
  float* out; char* ws;
};

constexpr size_t al(size_t x) { return (x + 255) & ~(size_t)255; }
constexpr size_t OFF_MOD = 0;                        constexpr size_t SZ_MOD = (size_t)2 * 9 * 6144 * 4;
constexpr size_t OFF_BAR = OFF_MOD + SZ_MOD;          constexpr size_t SZ_BAR = (size_t)3456 * 4;
constexpr size_t OFF_R16 = al(OFF_BAR + SZ_BAR);
constexpr size_t OFF_R8 = al(OFF_R16 + 64 * 16 * 2 * 4);
constexpr size_t OFF_WIN = al(OFF_R8 + 64 * 8 * 2 * 4);
constexpr size_t OFF_WUQ = al(OFF_WIN + (size_t)2 * 1792 * WP * 2);
constexpr size_t OFF_WUKV = al(OFF_WUQ + (size_t)2 * 384 * 256 * 2);
constexpr size_t OFF_WO = al(OFF_WUKV + (size_t)2 * 512 * 128 * 2);
constexpr size_t OFF_PWQ = al(OFF_WO + (size_t)2 * 1024 * WP * 2);
constexpr size_t OFF_PK = al(OFF_PWQ + (size_t)2 * 2048 * WP * 2);
constexpr size_t OFF_GWS = al(OFF_PK + (size_t)2 * 2 * 128 * 128 * 2);
constexpr size_t OFF_PU = al(OFF_GWS + (size_t)2 * 4 * 128 * 128 * 2);
constexpr size_t OFF_PV = al(OFF_PU + (size_t)2 * 16384 * 1024);
constexpr size_t OFF_SU = al(OFF_PV + (size_t)2 * 16384 * 1024);
constexpr size_t OFF_SV = al(OFF_SU + (size_t)2 * 16384 * 4);
constexpr size_t OFF_H = al(OFF_SV + (size_t)2 * 16384 * 4);
constexpr size_t OFF_PROJ = al(OFF_H + (size_t)T * HP * 2);
constexpr size_t OFF_MIXOUT = OFF_PROJ;
constexpr size_t OFF_MIXIN = OFF_PROJ + (size_t)T * MP * 4;
constexpr size_t OFF_ATT = al(OFF_PROJ + (size_t)T * PLD * 4);
constexpr size_t OFF_QA = OFF_ATT;
constexpr size_t OFF_CQ = OFF_QA + (size_t)T * 512 * 2;
constexpr size_t OFF_UC = OFF_CQ + (size_t)T * 256 * 2;
constexpr size_t OFF_VGT = OFF_UC + (size_t)T * 256 * 2;
constexpr size_t OFF_QM = OFF_VGT + (size_t)T * 256 * 2;
constexpr size_t OFF_KA = OFF_QM + (size_t)T * 384 * 2;
constexpr size_t OFF_VAT = OFF_KA + (size_t)NK * 128 * 2;
constexpr size_t OFF_CKV = OFF_VAT + (size_t)NK * 128 * 2;
constexpr size_t OFF_KM = OFF_CKV + (size_t)NK * 128 * 2;
constexpr size_t OFF_VMT = OFF_KM + (size_t)NK * 384 * 2;
constexpr size_t OFF_ATT_END = OFF_VMT + (size_t)NK * 256 * 2;
constexpr size_t OFF_H2 = OFF_ATT;
constexpr size_t OFF_TOPK = OFF_ATT + (size_t)T * HP * 2;
constexpr size_t OFF_SIDX = OFF_TOPK + (size_t)T * 256 * 4;
constexpr size_t OFF_SW = OFF_SIDX + (size_t)T * 128 * 4;
constexpr size_t OFF_SSU = OFF_SW + (size_t)T * 128 * 4;
static_assert(OFF_SSU + (size_t)T * 128 * 4 <= OFF_ATT_END, "alias overflow 3");
constexpr size_t WS_NEED = OFF_ATT_END;
static_assert(OFF_TOPK + (size_t)T * 256 * 4 <= OFF_ATT_END, "alias overflow");
static_assert(OFF_MIXIN + (size_t)T * HP * 2 <= OFF_ATT, "alias overflow 2");

constexpr size_t OUT_K = (size_t)T * 1024;
constexpr size_t OUT_V = OUT_K + 2097152;
constexpr size_t OUT_CKV = OUT_V + 2097152;
constexpr size_t OUT_KR = OUT_CKV + 2097152;

constexpr int SMEM_BYTES = 36864;

DI int tid_opaque() { int t = threadIdx.x; asm volatile("" : "+v"(t)); return t; }
DI unsigned pk2(float a, float b) { f32x2_t v = {a, b}; bf16x2_t r = __builtin_convertvector(v, bf16x2_t); return __builtin_bit_cast(unsigned, r); }
DI float bflo(unsigned u) { return __uint_as_float(u << 16); }
DI float bfhi(unsigned u) { return __uint_as_float(u & 0xffff0000u); }
#define DPPF(v, ctrl) __int_as_float(__builtin_amdgcn_update_dpp(0, __float_as_int(v), (ctrl), 0xF, 0xF, false))
DI float wave_sum(float v) {
  v += DPPF(v, 0xB1);
  v += DPPF(v, 0x4E);
  v += DPPF(v, 0x124);
  v += DPPF(v, 0x128);
  { const auto s16 = __builtin_amdgcn_permlane16_swap(__float_as_uint(v), __float_as_uint(v), false, false); v = __uint_as_float(s16[0]) + __uint_as_float(s16[1]); }
  { const auto s32 = __builtin_amdgcn_permlane32_swap(__float_as_uint(v), __float_as_uint(v), false, false); v = __uint_as_float(s32[0]) + __uint_as_float(s32[1]); }
  return v;
}
DI float wave_max(float v) {
  v = fmaxf(v, DPPF(v, 0xB1));
  v = fmaxf(v, DPPF(v, 0x4E));
  v = fmaxf(v, DPPF(v, 0x124));
  v = fmaxf(v, DPPF(v, 0x128));
  { const auto s16 = __builtin_amdgcn_permlane16_swap(__float_as_uint(v), __float_as_uint(v), false, false); v = fmaxf(__uint_as_float(s16[0]), __uint_as_float(s16[1])); }
  { const auto s32 = __builtin_amdgcn_permlane32_swap(__float_as_uint(v), __float_as_uint(v), false, false); v = fmaxf(__uint_as_float(s32[0]), __uint_as_float(s32[1])); }
  return v;
}
DI const float* xin_row(const Params& p, int t) { return t < TC ? p.x_prompt + (size_t)t * 1024 : p.x_sample + (size_t)(t - TC) * 1024; }
DI int tok_modrow(int t) { return t < TC ? 0 : 1 + ((t - TC) >> 11); }
DI int tok_keyrow(int t) { if (t < TC) return t; int u = t - TC; return TC + (u >> 11) * 2304 + 256 + (u & 2047); }
DI size_t vt_index(int kr, int ch, int C) {
  if (kr < TC) return ((size_t)((kr >> 8) * C + ch)) * 256 + (kr & 255);
  int u = kr - TC; int bl = u / 2304; int pos = u - bl * 2304;
  return (size_t)32 * C * 256 + ((size_t)(bl * C + ch)) * 2304 + pos;
}
DI float gelu_tanh(float x) {
  float u = 0.7978845608028654f * (x + 0.044715f * x * x * x);
  float e = __expf(2.f * u);
  float th = 1.f - 2.f * __builtin_amdgcn_rcpf(e + 1.f);
  return 0.5f * x * (1.f + th);
}

DI void ln_stats16(const float (&x)[16], float& mu, float& rstd) {
  float s = 0.f;
#pragma unroll
  for (int i = 0; i < 16; ++i) s += x[i];
  s = wave_sum(s); mu = s * (1.f / 1024.f);
  float q = 0.f;
#pragma unroll
  for (int i = 0; i < 16; ++i) { float d = x[i] - mu; q += d * d; }
  q = wave_sum(q);
  rstd = rsqrtf(q * (1.f / 1024.f) + EPS);
}

DI void transpose_tile(const float* __restrict__ src, int N, u16* __restrict__ dst, int ldd, int k0, int n0, char* smem) {
  float* s = (float*)smem;
  const int tid = tid_opaque();
  __syncthreads();
#pragma unroll
  for (int it = 0; it < 4; ++it) {
    int kk = (tid >> 4) + 16 * it, cn = (tid & 15) * 4;
    f32x4 v = {0.f, 0.f, 0.f, 0.f};
    if (n0 + cn < N) v = *(const f32x4*)(src + (size_t)(k0 + kk) * N + n0 + cn);
    s[kk * 65 + cn + 0] = v[0]; s[kk * 65 + cn + 1] = v[1]; s[kk * 65 + cn + 2] = v[2]; s[kk * 65 + cn + 3] = v[3];
  }
  __syncthreads();
#pragma unroll
  for (int it = 0; it < 2; ++it) {
    int id = tid + 256 * it, n = id >> 3, kc = id & 7;
    if (n0 + n < N) {
      u32x4 o;
#pragma unroll
      for (int e = 0; e < 4; ++e) o[e] = pk2(s[(kc * 8 + 2 * e) * 65 + n], s[(kc * 8 + 2 * e + 1) * 65 + n]);
      *(u32x4*)(dst + (size_t)(n0 + n) * ldd + k0 + kc * 8) = o;
    }
  }
}

DI void convert_task(const float* __restrict__ src, u16* __restrict__ dst, size_t base) {
  const int tid = tid_opaque();
#pragma unroll
  for (int it = 0; it < 2; ++it) {
    size_t i = base + (size_t)(it * 256 + tid) * 8;
    f32x4 a = *(const f32x4*)(src + i), b = *(const f32x4*)(src + i + 4);
    u32x4 o = {pk2(a[0], a[1]), pk2(a[2], a[3]), pk2(b[0], b[1]), pk2(b[2], b[3])};
    *(u32x4*)(dst + i) = o;
  }
}

DI void quant_rows_task(const float* __restrict__ src, unsigned char* __restrict__ dst, float* __restrict__ scl, int row0) {
  const int tid = tid_opaque(), lane = tid & 63, w = tid >> 6;
#pragma unroll 2
  for (int q = 0; q < 8; ++q) {
    const int row = row0 + w * 8 + q;
    const float* sp = src + (size_t)row * 1024 + lane * 16;
    f32x4 v[4];
    float am = 0.f;
#pragma unroll
    for (int i = 0; i < 4; ++i) { v[i] = *(const f32x4*)(sp + 4 * i); am = fmaxf(am, fmaxf(fmaxf(fabsf(v[i][0]), fabsf(v[i][1])), fmaxf(fabsf(v[i][2]), fabsf(v[i][3])))); }
    am = wave_max(am);
    const float sc = am > 0.f ? am * (1.f / 400.f) : 1.f;
    const float inv = 1.f / sc;
    u32x4 o;
#pragma unroll
    for (int i = 0; i < 4; ++i) {
      int wd = __builtin_amdgcn_cvt_pk_fp8_f32(v[i][0] * inv, v[i][1] * inv, 0, false);
      wd = __builtin_amdgcn_cvt_pk_fp8_f32(v[i][2] * inv, v[i][3] * inv, wd, true);
      o[i] = (unsigned)wd;
    }
    *(u32x4*)(dst + (size_t)row * 1024 + lane * 16) = o;
    if (lane == 0) scl[row] = sc;
  }
}

DI void quant_rows_fp4_task(const float* __restrict__ src, unsigned char* __restrict__ dst, float* __restrict__ scl, int row0) {
  const int tid = tid_opaque(), lane = tid & 63, w = tid >> 6;
#pragma unroll 2
  for (int q = 0; q < 8; ++q) {
    const int row = row0 + w * 8 + q;
    const float* sp = src + (size_t)row * 1024 + lane * 16;
    f32x4 v[4];
    float am = 0.f;
#pragma unroll
    for (int i = 0; i < 4; ++i) { v[i] = *(const f32x4*)(sp + 4 * i); am = fmaxf(am, fmaxf(fmaxf(fabsf(v[i][0]), fabsf(v[i][1])), fmaxf(fabsf(v[i][2]), fabsf(v[i][3])))); }
    am = wave_max(am);
    const float sc = am > 0.f ? am * (1.f / 6.f) : 1.f;
    const float inv = 1.f / sc;
    u32x2 o;
#pragma unroll
    for (int j = 0; j < 2; ++j) {
      unsigned wd = 0u;
      wd = __builtin_amdgcn_cvt_scalef32_pk_fp4_f32(wd, v[2 * j][0] * inv, v[2 * j][1] * inv, 1.0f, 0);
      wd = __builtin_amdgcn_cvt_scalef32_pk_fp4_f32(wd, v[2 * j][2] * inv, v[2 * j][3] * inv, 1.0f, 1);
      wd = __builtin_amdgcn_cvt_scalef32_pk_fp4_f32(wd, v[2 * j + 1][0] * inv, v[2 * j + 1][1] * inv, 1.0f, 2);
      wd = __builtin_amdgcn_cvt_scalef32_pk_fp4_f32(wd, v[2 * j + 1][2] * inv, v[2 * j + 1][3] * inv, 1.0f, 3);
      o[j] = wd;
    }
    *(u32x2*)(dst + (size_t)row * 512 + lane * 8) = o;
    if (lane == 0) scl[row] = sc;
  }
}

DI void prep_phase(const Params& p, char* smem) {
  const int tid = tid_opaque();
  constexpr int N_MOD = 768, N_TR_L = 1240, N_TR = 2 * N_TR_L;
  constexpr int B_TR = N_MOD, B_PK = B_TR + N_TR, B_GWS = B_PK + 16, B_PU = B_GWS + 32, B_PV = B_PU + 1024, B_ZP = B_PV + 1024, B_RT = B_ZP + 2, N_ALL = B_RT + 1;
  for (int task = blockIdx.x; task < N_ALL; task += gridDim.x) {
    if (task < B_TR) {
      const int l = task / 384, rem = task % 384, nc = rem >> 4, kc = rem & 15;
      float* sc = (float*)smem;
      __syncthreads();
      for (int e = tid; e < 576; e += 256) {
        int r = e >> 6, k = e & 63;
        float v = (r == 0) ? p.c_ctx[kc * 64 + k] : p.c[(r - 1) * 1024 + kc * 64 + k];
        sc[e] = v / (1.f + __expf(-v));
      }
      __syncthreads();
      const int n = nc * 256 + tid;
      const float* w = p.w_mod + ((size_t)l * 1024 + kc * 64) * 6144 + n;
      float acc[9];
#pragma unroll
      for (int r = 0; r < 9; ++r) acc[r] = 0.f;
#pragma unroll 8
      for (int k = 0; k < 64; ++k) {
        float wv = w[(size_t)k * 6144];
#pragma unroll
        for (int r = 0; r < 9; ++r) acc[r] += sc[r * 64 + k] * wv;
      }
      float* mod = (float*)(p.ws + OFF_MOD) + (size_t)l * 9 * 6144;
      float bias = (kc == 0) ? p.b_mod[l * 6144 + n] : 0.f;
#pragma unroll
      for (int r = 0; r < 9; ++r) unsafeAtomicAdd(&mod[r * 6144 + n], acc[r] + bias);
    } else if (task < B_PK) {
      int j = task - B_TR; const int l = j / N_TR_L; int r = j % N_TR_L;
      if (r < 432) { int kt = r / 27, nt = r % 27; transpose_tile(p.w_in + (size_t)l * 1024 * 1696, 1696, (u16*)(p.ws + OFF_WIN) + (size_t)l * 1792 * WP, WP, kt * 64, nt * 64, smem); }
      else if (r < 456) { r -= 432; int kt = r / 6, nt = r % 6; transpose_tile(p.w_uq + (size_t)l * 256 * 384, 384, (u16*)(p.ws + OFF_WUQ) + (size_t)l * 384 * 256, 256, kt * 64, nt * 64, smem); }
      else if (r < 472) { r -= 456; int kt = r / 8, nt = r % 8; transpose_tile(p.w_ukv + (size_t)l * 128 * 512, 512, (u16*)(p.ws + OFF_WUKV) + (size_t)l * 512 * 128, 128, kt * 64, nt * 64, smem); }
      else if (r < 728) { r -= 472; int kt = r / 16, nt = r % 16; transpose_tile(p.w_o + (size_t)l * 1024 * 1024, 1024, (u16*)(p.ws + OFF_WO) + (size_t)l * 1024 * WP, WP, kt * 64, nt * 64, smem); }
      else { r -= 728; int kt = r / 32, nt = r % 32; transpose_tile(p.pwq + (size_t)l * 1024 * 2048, 2048, (u16*)(p.ws + OFF_PWQ) + (size_t)l * 2048 * WP, WP, kt * 64, nt * 64, smem); }
    } else if (task < B_GWS) {
      int j = task - B_PK;
      int l = j >> 3, half = (j >> 2) & 1, ch = j & 3;
      const float* src = (half ? p.pk2 : p.pk1) + (size_t)l * 16384;
      convert_task(src, (u16*)(p.ws + OFF_PK) + (size_t)(l * 2 + half) * 16384, (size_t)ch * 4096);
    } else if (task < B_PU) {
      convert_task(p.gws, (u16*)(p.ws + OFF_GWS), (size_t)(task - B_GWS) * 4096);
    } else if (task < B_PV) {
      quant_rows_fp4_task(p.pu, (unsigned char*)(p.ws + OFF_PU), (float*)(p.ws + OFF_SU), (task - B_PU) * 32);
    } else if (task < B_ZP) {
      quant_rows_fp4_task(p.pv, (unsigned char*)(p.ws + OFF_PV), (float*)(p.ws + OFF_SV), (task - B_PV) * 32);
    } else if (task < B_RT) {
      int l = task - B_ZP;
      u16* dst = (u16*)(p.ws + OFF_WIN) + ((size_t)l * 1792 + 1696) * WP;
      u32x4 z = {0u, 0u, 0u, 0u};
      for (int c = tid; c < 96 * WP / 8; c += 256) *(u32x4*)(dst + (size_t)c * 8) = z;
    } else {
      float* r16 = (float*)(p.ws + OFF_R16); float* r8 = (float*)(p.ws + OFF_R8);
      for (int e = tid; e < 1024; e += 256) {
        int pos = e >> 4, f = e & 15;
        float fr = exp2f(-(float)f * (13.287712379549449f / 16.f));
        float ang = (float)pos * fr;
        r16[e * 2] = __cosf(ang); r16[e * 2 + 1] = __sinf(ang);
      }
      for (int e = tid; e < 512; e += 256) {
        int pos = e >> 3, f = e & 7;
        float fr = exp2f(-(float)f * (13.287712379549449f / 8.f));
        float ang = (float)pos * fr;
        r8[e * 2] = __cosf(ang); r8[e * 2 + 1] = __sinf(ang);
      }
    }
  }
}


DI void s0_phase(const Params& p) {
  const int lane = tid_opaque() & 63, w = tid_opaque() >> 6;
  u16* H = (u16*)(p.ws + OFF_H);
  for (int t = blockIdx.x * 4 + w; t < T; t += gridDim.x * 4) {
    const float* xr = xin_row(p, t);
    float x[16];
#pragma unroll
    for (int i = 0; i < 4; ++i) { f32x4 v = *(const f32x4*)(xr + 4 * (lane + 64 * i)); x[4 * i] = v[0]; x[4 * i + 1] = v[1]; x[4 * i + 2] = v[2]; x[4 * i + 3] = v[3]; }
    float mu, rstd; ln_stats16(x, mu, rstd);
    const float* m = (const float*)(p.ws + OFF_MOD) + (size_t)tok_modrow(t) * 6144;
#pragma unroll
    for (int i = 0; i < 4; ++i) {
      int c = 4 * (lane + 64 * i);
      f32x4 sh = *(const f32x4*)(m + c), sc = *(const f32x4*)(m + 1024 + c);
      float h0 = (x[4 * i] - mu) * rstd * (1.f + sc[0]) + sh[0];
      float h1 = (x[4 * i + 1] - mu) * rstd * (1.f + sc[1]) + sh[1];
      float h2 = (x[4 * i + 2] - mu) * rstd * (1.f + sc[2]) + sh[2];
      float h3 = (x[4 * i + 3] - mu) * rstd * (1.f + sc[3]) + sh[3];
      u32x2 o = {pk2(h0, h1), pk2(h2, h3)};
      *(u32x2*)(H + (size_t)t * HP + c) = o;
    }
  }
}

DI void gemm_mainloop(const u16* __restrict__ A, int lda, const u16* __restrict__ B, int ldb, int K, char* smem, f32x16 (&acc)[2][2], int nact = 4) {
  const int tid = tid_opaque(), lane = tid & 63, w = tid >> 6, wm = w >> 1, wn = w & 1, r = lane & 31, g = lane >> 5;
  char* As = smem; char* Bs = smem + 128 * 144;
#pragma unroll
  for (int mi = 0; mi < 2; ++mi)
#pragma unroll
    for (int ni = 0; ni < 2; ++ni)
#pragma unroll
      for (int i = 0; i < 16; ++i) acc[mi][ni][i] = 0.f;
  u32x4 ra[4], rb[4];
  const int lrow = tid >> 3, lkc = tid & 7;
  const u16* ga = A + (size_t)lrow * lda + lkc * 8;
  const u16* gb = B + (size_t)lrow * ldb + lkc * 8;
#pragma unroll
  for (int i = 0; i < 4; ++i) { ra[i] = *(const u32x4*)(ga + (size_t)(32 * i) * lda); rb[i] = *(const u32x4*)(gb + (size_t)(32 * i) * ldb); }
  for (int k0 = 0; k0 < K; k0 += 64) {
    __syncthreads();
#pragma unroll
    for (int i = 0; i < 4; ++i) {
      *(u32x4*)(As + (lrow + 32 * i) * 144 + lkc * 16) = ra[i];
      *(u32x4*)(Bs + (lrow + 32 * i) * 144 + lkc * 16) = rb[i];
    }
    __syncthreads();
    if (k0 + 64 < K) {
#pragma unroll
      for (int i = 0; i < 4; ++i) { ra[i] = *(const u32x4*)(ga + (size_t)(32 * i) * lda + k0 + 64); rb[i] = *(const u32x4*)(gb + (size_t)(32 * i) * ldb + k0 + 64); }
    }
    __builtin_amdgcn_s_setprio(2);
    if (2 * wm + 1 < nact) {
#pragma unroll
      for (int ks = 0; ks < 4; ++ks) {
        bf16x8 af[2], bfr[2];
#pragma unroll
        for (int mi = 0; mi < 2; ++mi) af[mi] = *(const bf16x8*)(As + (64 * wm + 32 * mi + r) * 144 + (16 * ks + 8 * g) * 2);
#pragma unroll
        for (int ni = 0; ni < 2; ++ni) bfr[ni] = *(const bf16x8*)(Bs + (64 * wn + 32 * ni + r) * 144 + (16 * ks + 8 * g) * 2);
#pragma unroll
        for (int mi = 0; mi < 2; ++mi)
#pragma unroll
          for (int ni = 0; ni < 2; ++ni) acc[mi][ni] = MFMA32(af[mi], bfr[ni], acc[mi][ni]);
      }
    } else if (2 * wm < nact) {
#pragma unroll
      for (int ks = 0; ks < 4; ++ks) {
        const bf16x8 af0 = *(const bf16x8*)(As + (64 * wm + r) * 144 + (16 * ks + 8 * g) * 2);
#pragma unroll
        for (int ni = 0; ni < 2; ++ni) {
          const bf16x8 bf0 = *(const bf16x8*)(Bs + (64 * wn + 32 * ni + r) * 144 + (16 * ks + 8 * g) * 2);
          acc[0][ni] = MFMA32(af0, bf0, acc[0][ni]);
        }
      }
    }
    __builtin_amdgcn_s_setprio(0);
  }
}

DI void epi_store_f32(const f32x16 (&acc)[2][2], float* __restrict__ C, int ldc, int n0, int t0) {
  const int lane = tid_opaque() & 63, w = tid_opaque() >> 6, wm = w >> 1, wn = w & 1, r = lane & 31, g = lane >> 5;
#pragma unroll
  for (int mi = 0; mi < 2; ++mi)
#pragma unroll
    for (int ni = 0; ni < 2; ++ni) {
      const int t = t0 + 64 * wn + 32 * ni + r;
#pragma unroll
      for (int i = 0; i < 4; ++i) {
        const int n = n0 + 64 * wm + 32 * mi + 8 * i + 4 * g;
        f32x4 v = {acc[mi][ni][4 * i], acc[mi][ni][4 * i + 1], acc[mi][ni][4 * i + 2], acc[mi][ni][4 * i + 3]};
        *(f32x4*)(C + (size_t)t * ldc + n) = v;
      }
    }
}

DI void g1_phase(const Params& p, int l, char* smem) {
  const u16* W = (const u16*)(p.ws + OFF_WIN) + (size_t)l * 1792 * WP;
  const u16* H = (const u16*)(p.ws + OFF_H);
  float* PROJ = (float*)(p.ws + OFF_PROJ);
  const int xq = blockIdx.x & 7, qq = blockIdx.x >> 3, nbx = (int)((gridDim.x - xq + 7) >> 3);
  for (int i = qq; i < 24 * 14; i += nbx) {
    const int tt = (i / 14) * 8 + xq, nt = i % 14;
    f32x16 acc[2][2];
    gemm_mainloop(W + (size_t)nt * 128 * WP, WP, H + (size_t)tt * 128 * HP, HP, 1024, smem, acc, nt == 13 ? 1 : 4);
    epi_store_f32(acc, PROJ, PLD, nt * 128, tt * 128);
  }
}

DI void rope16_apply(float (&v)[8], int c, int rowp, int colp, const float* __restrict__ r16) {
  const int pos = (c < 4) ? rowp : colp;
  const float* tb = r16 + (size_t)(pos * 16 + (c & 1) * 8) * 2;
  const bool is_x1 = (c & 2) == 0;
#pragma unroll
  for (int e = 0; e < 8; ++e) {
    float pv = DPPF(v[e], 0x4E);
    float cs = tb[2 * e], sn = tb[2 * e + 1];
    v[e] = is_x1 ? (v[e] * cs - pv * sn) : (pv * sn + v[e] * cs);
  }
}

DI void r1_phase(const Params& p, int l, char* smem) {
  const int tid = tid_opaque(), lane = tid & 63, w = tid >> 6;
  u16* sT = (u16*)smem;
  const float* PROJ = (const float*)(p.ws + OFF_PROJ);
  const float* r16 = (const float*)(p.ws + OFF_R16);
  const float* r8 = (const float*)(p.ws + OFF_R8);
  u16* QA = (u16*)(p.ws + OFF_QA); u16* CQ = (u16*)(p.ws + OFF_CQ); u16* UC = (u16*)(p.ws + OFF_UC); u16* VGT = (u16*)(p.ws + OFF_VGT);
  u16* KA = (u16*)(p.ws + OFF_KA); u16* VAT = (u16*)(p.ws + OFF_VAT); u16* CKV = (u16*)(p.ws + OFF_CKV); u16* KM = (u16*)(p.ws + OFF_KM);
  const float* aqn = p.aqn + l * 64; const float* akn = p.akn + l * 64; const float* mqn = p.mqn + l * 256; const float* mkvn = p.mkvn + l * 128;
  constexpr int NTB = T / 32;
  for (int task0 = blockIdx.x; task0 < NTB + 64; task0 += gridDim.x) {
    const int task = (task0 < 64) ? (NTB + task0) : (task0 - 64);
    __syncthreads();
    if (task < NTB) {
      const int t0 = task * 32;
      for (int q = 0; q < 8; ++q) {
        const int tl = w * 8 + q, t = t0 + tl;
        const float* pr = PROJ + (size_t)t * PLD;
        const bool lat = t >= TC;
        const int s = lat ? ((t - TC) & 2047) : (t & 255);
        const int bctx = t >> 8;
        const int rowp = s >> 6, colp = s & 63;
        const int kr = tok_keyrow(t);
        const int c = lane & 7;
        {
          f32x4 a = *(const f32x4*)(pr + lane * 8), b = *(const f32x4*)(pr + lane * 8 + 4);
          float v[8] = {a[0], a[1], a[2], a[3], b[0], b[1], b[2], b[3]};
          float ss = 0.f;
#pragma unroll
          for (int e = 0; e < 8; ++e) ss += v[e] * v[e];
          ss += DPPF(ss, 0xB1); ss += DPPF(ss, 0x4E); ss += DPPF(ss, 0x141);
          float rinv = rsqrtf(ss * (1.f / 64.f) + EPS);
#pragma unroll
          for (int e = 0; e < 8; ++e) v[e] = v[e] * rinv * aqn[c * 8 + e];
          if (lat) rope16_apply(v, c, rowp, colp, r16);
          const float sc = 0.125f * LOG2E;
          u32x4 o = {pk2(v[0] * sc, v[1] * sc), pk2(v[2] * sc, v[3] * sc), pk2(v[4] * sc, v[5] * sc), pk2(v[6] * sc, v[7] * sc)};
          *(u32x4*)(QA + (size_t)t * 512 + lane * 8) = o;
        }
        {
          const int ln = lane & 31;
          f32x4 a = *(const f32x4*)(pr + 512 + ln * 8), b = *(const f32x4*)(pr + 512 + ln * 8 + 4);
          float v[8] = {a[0], a[1], a[2], a[3], b[0], b[1], b[2], b[3]};
          float ss = 0.f;
#pragma unroll
          for (int e = 0; e < 8; ++e) ss += v[e] * v[e];
          ss += DPPF(ss, 0xB1); ss += DPPF(ss, 0x4E); ss += DPPF(ss, 0x141);
          float rinv = rsqrtf(ss * (1.f / 64.f) + EPS);
          float kv[8];
#pragma unroll
          for (int e = 0; e < 8; ++e) kv[e] = v[e] * rinv * akn[c * 8 + e];
          if (!lat && lane < 16) {
            float* o = p.out + OUT_K + ((size_t)((bctx * 2 + l) * 256 + s)) * 128 + lane * 8;
            f32x4 o0 = {kv[0], kv[1], kv[2], kv[3]}, o1 = {kv[4], kv[5], kv[6], kv[7]};
            *(f32x4*)o = o0; *(f32x4*)(o + 4) = o1;
          }
          if (lat) rope16_apply(kv, c, rowp, colp, r16);
          if (lane < 16) {
            u32x4 o = {pk2(kv[0], kv[1]), pk2(kv[2], kv[3]), pk2(kv[4], kv[5]), pk2(kv[6], kv[7])};
            *(u32x4*)(KA + (size_t)kr * 128 + lane * 8) = o;
          } else if (lane < 32) {
            const int ch = (lane - 16) * 8;
            if (!lat) {
              float* o = p.out + OUT_V + ((size_t)((bctx * 2 + l) * 256 + s)) * 128 + ch;
              *(f32x4*)o = a; *(f32x4*)(o + 4) = b;
            }
#pragma unroll
            for (int e = 0; e < 8; ++e) sT[(ch + e) * 40 + tl] = (u16)(pk2(v[e], 0.f) & 0xffffu);
          }
        }
        {
          f32x4 a = *(const f32x4*)(pr + 768 + lane * 4);
          float ss = a[0] * a[0] + a[1] * a[1] + a[2] * a[2] + a[3] * a[3];
          ss = wave_sum(ss);
          float rinv = rsqrtf(ss * (1.f / 256.f) + EPS);
          f32x4 gq = *(const f32x4*)(mqn + lane * 4);
          u32x2 o = {pk2(a[0] * rinv * gq[0], a[1] * rinv * gq[1]), pk2(a[2] * rinv * gq[2], a[3] * rinv * gq[3])};
          *(u32x2*)(CQ + (size_t)t * 256 + lane * 4) = o;
        }
        {
          f32x2_t a = *(const f32x2_t*)(pr + 1024 + lane * 2);
          float ss = wave_sum(a[0] * a[0] + a[1] * a[1]);
          float rinv = rsqrtf(ss * (1.f / 128.f) + EPS);
          float c0 = a[0] * rinv * mkvn[lane * 2], c1 = a[1] * rinv * mkvn[lane * 2 + 1];
          if (!lat) { f32x2_t o = {c0, c1}; *(f32x2_t*)(p.out + OUT_CKV + ((size_t)((bctx * 2 + l) * 256 + s)) * 128 + lane * 2) = o; }
          *(unsigned*)(CKV + (size_t)kr * 128 + lane * 2) = pk2(c0, c1);
        }
        {
          const int ln = lane & 31;
          float v = pr[1152 + ln];
          if (!lat && lane < 32) p.out[OUT_KR + ((size_t)((bctx * 2 + l) * 256 + s)) * 32 + ln] = v;
          if (lat) {
            float pv = DPPF(v, 0x128);
            const int pos = (ln >> 4) ? colp : rowp;
            const float* tb = r8 + (size_t)(pos * 8 + (ln & 7)) * 2;
            float cs = tb[0], sn = tb[1];
            v = (ln & 8) ? (pv * sn + v * cs) : (v * cs - pv * sn);
          }
          if (lane < 32) {
            u16 hv = (u16)(pk2(v, 0.f) & 0xffffu);
#pragma unroll
            for (int h = 0; h < 4; ++h) KM[(size_t)kr * 384 + h * 96 + 64 + ln] = hv;
          }
        }
        {
          f32x4 a = *(const f32x4*)(pr + 1184 + lane * 4);
          u32x2 o = {pk2(a[0], a[1]), pk2(a[2], a[3])};
          *(u32x2*)(UC + (size_t)t * 256 + lane * 4) = o;
        }
        {
          f32x4 a = *(const f32x4*)(pr + 1440 + lane * 4);
          float sm = a[0] + a[1] + a[2] + a[3];
          sm += DPPF(sm, 0xB1); sm += DPPF(sm, 0x4E); sm += DPPF(sm, 0x141); sm += DPPF(sm, 0x140);
          float mu = sm * (1.f / 64.f);
          float d0 = a[0] - mu, d1 = a[1] - mu, d2 = a[2] - mu, d3 = a[3] - mu;
          float q2 = d0 * d0 + d1 * d1 + d2 * d2 + d3 * d3;
          q2 += DPPF(q2, 0xB1); q2 += DPPF(q2, 0x4E); q2 += DPPF(q2, 0x141); q2 += DPPF(q2, 0x140);
          float rstd = rsqrtf(q2 * (1.f / 64.f) + EPS);
          unsigned u0 = pk2(d0 * rstd, d1 * rstd), u1 = pk2(d2 * rstd, d3 * rstd);
          const int ch = 128 + lane * 4;
          sT[(ch + 0) * 40 + tl] = (u16)(u0 & 0xffffu); sT[(ch + 1) * 40 + tl] = (u16)(u0 >> 16);
          sT[(ch + 2) * 40 + tl] = (u16)(u1 & 0xffffu); sT[(ch + 3) * 40 + tl] = (u16)(u1 >> 16);
        }
      }
      __syncthreads();
      const int kr0 = tok_keyrow(t0);
      const int chunk = t0 >> 7, q0 = t0 & 127;
#pragma unroll
      for (int it = 0; it < 6; ++it) {
        int id = tid + 256 * it, row = id >> 2, cc = id & 3;
        u32x4 v = *(const u32x4*)(sT + row * 40 + cc * 8);
        if (row < 128) *(u32x4*)(VAT + vt_index(kr0, row, 128) + cc * 8) = v;
        else { int gd = row - 128; *(u32x4*)(VGT + ((size_t)(chunk * 256 + gd)) * 128 + q0 + cc * 8) = v; }
      }
    } else {
      const int j = task - NTB, bl = j >> 3, p0 = (j & 7) * 32;
      for (int q = 0; q < 8; ++q) {
        const int tl = w * 8 + q, pp = p0 + tl;
        const size_t crow = (size_t)((bl * 2 + l) * 256 + pp);
        const int kr = TC + bl * 2304 + pp;
        f32x2_t k2 = *(const f32x2_t*)(p.cache_k + crow * 128 + lane * 2);
        *(unsigned*)(KA + (size_t)kr * 128 + lane * 2) = pk2(k2[0], k2[1]);
        f32x2_t v2 = *(const f32x2_t*)(p.cache_v + crow * 128 + lane * 2);
        unsigned uv = pk2(v2[0], v2[1]);
        sT[(lane * 2) * 40 + tl] = (u16)(uv & 0xffffu); sT[(lane * 2 + 1) * 40 + tl] = (u16)(uv >> 16);
        f32x2_t c2 = *(const f32x2_t*)(p.cache_ckv + crow * 128 + lane * 2);
        *(unsigned*)(CKV + (size_t)kr * 128 + lane * 2) = pk2(c2[0], c2[1]);
        if (lane < 32) {
          float v = p.cache_kr[crow * 32 + lane];
          u16 hv = (u16)(pk2(v, 0.f) & 0xffffu);
#pragma unroll
          for (int h = 0; h < 4; ++h) KM[(size_t)kr * 384 + h * 96 + 64 + lane] = hv;
        }
      }
      __syncthreads();
      const int kr0 = TC + bl * 2304 + p0;
#pragma unroll
      for (int it = 0; it < 2; ++it) {
        int id = tid + 256 * it, row = id >> 2, cc = id & 3;
        u32x4 v = *(const u32x4*)(sT + row * 40 + cc * 8);
        *(u32x4*)(VAT + vt_index(kr0, row, 128) + cc * 8) = v;
      }
    }
  }
}

DI void mid_phase(const Params& p, int l, char* smem) {
  const int tid = tid_opaque(), lane = tid & 63, w = tid >> 6, wm = w >> 1, wn = w & 1, r = lane & 31, g = lane >> 5;
  constexpr int N_G2 = 192 * 3, N_G3 = 208 * 4, N_C1 = 192 * 4;
  for (int task = blockIdx.x; task < N_G2 + N_G3 + N_C1; task += gridDim.x) {
    if (task < N_G2) {
      const int tt = task / 3, nt = task % 3;
      const u16* W = (const u16*)(p.ws + OFF_WUQ) + (size_t)l * 384 * 256;
      const u16* CQ = (const u16*)(p.ws + OFF_CQ);
      u16* QM = (u16*)(p.ws + OFF_QM);
      const float* r8 = (const float*)(p.ws + OFF_R8);
      f32x16 acc[2][2];
      gemm_mainloop(W + (size_t)nt * 128 * 256, 256, CQ + (size_t)tt * 128 * 256, 256, 256, smem, acc);
      const float sc = LOG2E * 0.10206207261596577f;
#pragma unroll
      for (int mi = 0; mi < 2; ++mi) {
        const int nb = nt * 128 + 64 * wm + 32 * mi;
        const bool is_rope = (nb % 96) == 64;
#pragma unroll
        for (int ni = 0; ni < 2; ++ni) {
          const int t = tt * 128 + 64 * wn + 32 * ni + r;
          float v[16];
#pragma unroll
          for (int i = 0; i < 16; ++i) v[i] = acc[mi][ni][i];
          if (is_rope && t >= TC) {
            const int s = (t - TC) & 2047, rowp = s >> 6, colp = s & 63;
#pragma unroll
            for (int j = 0; j < 4; ++j) {
              const float* tb = r8 + (size_t)(rowp * 8 + 4 * g + j) * 2;
              float cs = tb[0], sn = tb[1];
              float x1 = v[j], x2 = v[4 + j];
              v[j] = x1 * cs - x2 * sn; v[4 + j] = x1 * sn + x2 * cs;
              const float* tc = r8 + (size_t)(colp * 8 + 4 * g + j) * 2;
              cs = tc[0]; sn = tc[1];
              x1 = v[8 + j]; x2 = v[12 + j];
              v[8 + j] = x1 * cs - x2 * sn; v[12 + j] = x1 * sn + x2 * cs;
            }
          }
#pragma unroll
          for (int i = 0; i < 4; ++i) {
            u32x2 o = {pk2(v[4 * i] * sc, v[4 * i + 1] * sc), pk2(v[4 * i + 2] * sc, v[4 * i + 3] * sc)};
            *(u32x2*)(QM + (size_t)t * 384 + nb + 8 * i + 4 * g) = o;
          }
        }
      }
    } else if (task < N_G2 + N_G3) {
      const int j = task - N_G2, tt = j >> 2, h = j & 3;
      const u16* W = (const u16*)(p.ws + OFF_WUKV) + (size_t)l * 512 * 128;
      const u16* CKV = (const u16*)(p.ws + OFF_CKV);
      u16* KM = (u16*)(p.ws + OFF_KM); u16* VMT = (u16*)(p.ws + OFF_VMT);
      f32x16 acc[2][2];
      gemm_mainloop(W + (size_t)h * 128 * 128, 128, CKV + (size_t)tt * 128 * 128, 128, 128, smem, acc);
#pragma unroll
      for (int mi = 0; mi < 2; ++mi)
#pragma unroll
        for (int ni = 0; ni < 2; ++ni) {
          const int kr = tt * 128 + 64 * wn + 32 * ni + r;
          if (wm == 0) {
#pragma unroll
            for (int i = 0; i < 4; ++i) {
              u32x2 o = {pk2(acc[mi][ni][4 * i], acc[mi][ni][4 * i + 1]), pk2(acc[mi][ni][4 * i + 2], acc[mi][ni][4 * i + 3])};
              *(u32x2*)(KM + (size_t)kr * 384 + h * 96 + 32 * mi + 8 * i + 4 * g) = o;
            }
          } else {
            size_t vbase; int lseq;
            if (kr < TC) { vbase = (size_t)(kr >> 8) * 256 * 256 + (kr & 255); lseq = 256; }
            else { const int u = kr - TC, bl = u / 2304, pos = u - bl * 2304; vbase = (size_t)32 * 256 * 256 + (size_t)bl * 256 * 2304 + pos; lseq = 2304; }
            u16* vp = VMT + vbase + (size_t)(h * 64 + 32 * mi + 4 * g) * lseq;
#pragma unroll
            for (int i = 0; i < 16; ++i)
              vp[(size_t)(8 * (i >> 2) + (i & 3)) * lseq] = (u16)(pk2(acc[mi][ni][i], 0.f) & 0xffffu);
          }
        }
    } else {
      const int j = task - N_G2 - N_G3, chunk = j >> 2, gg = j & 3;
      const u16* WS = (const u16*)(p.ws + OFF_GWS) + (size_t)(l * 4 + gg) * 128 * 128;
      const u16* VGT = (const u16*)(p.ws + OFF_VGT) + (size_t)(chunk * 4 + gg) * 64 * 128;
      const u16* UC = (const u16*)(p.ws + OFF_UC);
      u16* MIXIN = (u16*)(p.ws + OFF_MIXIN);
      f32x16 acc[2];
#pragma unroll
      for (int i = 0; i < 16; ++i) { acc[0][i] = 0.f; acc[1][i] = 0.f; }
      const int pp = 32 * w + r;
#pragma unroll
      for (int ks = 0; ks < 8; ++ks) {
        bf16x8 b = *(const bf16x8*)(WS + (size_t)pp * 128 + ks * 16 + 8 * g);
#pragma unroll
        for (int mt = 0; mt < 2; ++mt) {
          bf16x8 a = *(const bf16x8*)(VGT + (size_t)(32 * mt + r) * 128 + ks * 16 + 8 * g);
          acc[mt] = MFMA32(a, b, acc[mt]);
        }
      }
      const float bs = p.gb[(size_t)(l * 4 + gg) * 128 + pp];
      const int t = chunk * 128 + pp;
#pragma unroll
      for (int mt = 0; mt < 2; ++mt)
#pragma unroll
        for (int i = 0; i < 4; ++i) {
          const int d = 32 * mt + 8 * i + 4 * g;
          u32x2 u = *(const u32x2*)(UC + (size_t)t * 256 + gg * 64 + d);
          float o0 = bflo(u[0]) * (acc[mt][4 * i] + bs), o1 = bfhi(u[0]) * (acc[mt][4 * i + 1] + bs);
          float o2 = bflo(u[1]) * (acc[mt][4 * i + 2] + bs), o3 = bfhi(u[1]) * (acc[mt][4 * i + 3] + bs);
          u32x2 o = {pk2(o0, o1), pk2(o2, o3)};
          *(u32x2*)(MIXIN + (size_t)t * HP + 768 + gg * 64 + d) = o;
        }
    }
  }
}

template <int DK>
DI void attn_item(const u16* __restrict__ Q, int ldq, const u16* __restrict__ Kp, int ldk, const u16* __restrict__ VT, int L,
                  u16* __restrict__ O, char* smem) {
  constexpr int KS = DK / 16, KROW = (DK + 8) * 2, KCH = DK / 8, NKC = 64 * KCH / 256;
  const int tid = tid_opaque(), lane = tid & 63, w = tid >> 6, r = lane & 31, g = lane >> 5;
  char* Ks = smem; char* Vs = smem + 64 * KROW;
  bf16x8 qf[KS];
  {
    const u16* qrow = Q + (size_t)(32 * w + r) * ldq + 8 * g;
#pragma unroll
    for (int ks = 0; ks < KS; ++ks) qf[ks] = *(const bf16x8*)(qrow + 16 * ks);
  }
  f32x16 o[2];
#pragma unroll
  for (int i = 0; i < 16; ++i) { o[0][i] = 0.f; o[1][i] = 0.f; }
  float m = -1e30f, lsum = 0.f;
  u32x4 kreg[NKC], vreg[2];
#pragma unroll
  for (int i = 0; i < NKC; ++i) { int id = tid + 256 * i, row = id / KCH, c = id % KCH; kreg[i] = *(const u32x4*)(Kp + (size_t)row * ldk + c * 8); }
#pragma unroll
  for (int i = 0; i < 2; ++i) { int id = tid + 256 * i, row = id >> 3, c = id & 7; vreg[i] = *(const u32x4*)(VT + (size_t)row * L + c * 8); }
  for (int key0 = 0; key0 < L; key0 += 64) {
    __syncthreads();
#pragma unroll
    for (int i = 0; i < NKC; ++i) { int id = tid + 256 * i, row = id / KCH, c = id % KCH; *(u32x4*)(Ks + row * KROW + c * 16) = kreg[i]; }
#pragma unroll
    for (int i = 0; i < 2; ++i) { int id = tid + 256 * i, row = id >> 3, c = id & 7; *(u32x4*)(Vs + row * 144 + c * 16) = vreg[i]; }
    __syncthreads();
    if (key0 + 64 < L) {
      const int kn = key0 + 64;
#pragma unroll
      for (int i = 0; i < NKC; ++i) { int id = tid + 256 * i, row = id / KCH, c = id % KCH; kreg[i] = *(const u32x4*)(Kp + (size_t)(kn + row) * ldk + c * 8); }
#pragma unroll
      for (int i = 0; i < 2; ++i) { int id = tid + 256 * i, row = id >> 3, c = id & 7; vreg[i] = *(const u32x4*)(VT + (size_t)row * L + kn + c * 8); }
    }
    __builtin_amdgcn_s_setprio(2);
    f32x16 s[2];
#pragma unroll
    for (int i = 0; i < 16; ++i) { s[0][i] = 0.f; s[1][i] = 0.f; }
#pragma unroll
    for (int ks = 0; ks < KS; ++ks)
#pragma unroll
      for (int mt = 0; mt < 2; ++mt) {
        bf16x8 a = *(const bf16x8*)(Ks + (32 * mt + r) * KROW + (16 * ks + 8 * g) * 2);
        s[mt] = MFMA32(a, qf[ks], s[mt]);
      }
    float mx = s[0][0];
#pragma unroll
    for (int i = 0; i < 16; ++i) { mx = fmaxf(mx, s[0][i]); mx = fmaxf(mx, s[1][i]); }
    mx = fmaxf(mx, __shfl_xor(mx, 32));
    const float mnew = fmaxf(m, mx);
    const float alpha = __builtin_amdgcn_exp2f(m - mnew);
    m = mnew;
    float ps = 0.f;
#pragma unroll
    for (int mt = 0; mt < 2; ++mt)
#pragma unroll
      for (int i = 0; i < 16; ++i) { float e = __builtin_amdgcn_exp2f(s[mt][i] - mnew); s[mt][i] = e; ps += e; }
    lsum = lsum * alpha + ps;
#pragma unroll
    for (int i = 0; i < 16; ++i) { o[0][i] *= alpha; o[1][i] *= alpha; }
#pragma unroll
    for (int mt = 0; mt < 2; ++mt)
#pragma unroll
      for (int ip = 0; ip < 2; ++ip) {
        u32x4 pb = {pk2(s[mt][8 * ip], s[mt][8 * ip + 1]), pk2(s[mt][8 * ip + 2], s[mt][8 * ip + 3]),
                    pk2(s[mt][8 * ip + 4], s[mt][8 * ip + 5]), pk2(s[mt][8 * ip + 6], s[mt][8 * ip + 7])};
        bf16x8 pbv = __builtin_bit_cast(bf16x8, pb);
#pragma unroll
        for (int dt = 0; dt < 2; ++dt) {
          const char* vrow = Vs + (32 * dt + r) * 144 + (32 * mt + 16 * ip + 4 * g) * 2;
          u32x2 lo = *(const u32x2*)(vrow), hi = *(const u32x2*)(vrow + 16);
          u32x4 av = {lo[0], lo[1], hi[0], hi[1]};
          o[dt] = MFMA32(__builtin_bit_cast(bf16x8, av), pbv, o[dt]);
        }
      }
    __builtin_amdgcn_s_setprio(0);
  }
  lsum += __shfl_xor(lsum, 32);
  const float inv = 1.f / lsum;
  u16* orow = O + (size_t)(32 * w + r) * HP;
#pragma unroll
  for (int dt = 0; dt < 2; ++dt)
#pragma unroll
    for (int i = 0; i < 4; ++i) {
      u32x2 ov = {pk2(o[dt][4 * i] * inv, o[dt][4 * i + 1] * inv), pk2(o[dt][4 * i + 2] * inv, o[dt][4 * i + 3] * inv)};
      *(u32x2*)(orow + 32 * dt + 8 * i + 4 * g) = ov;
    }
}

DI void attn_phase(const Params& p, char* smem) {
  const u16* QA = (const u16*)(p.ws + OFF_QA); const u16* QM = (const u16*)(p.ws + OFF_QM);
  const u16* KA = (const u16*)(p.ws + OFF_KA); const u16* KM = (const u16*)(p.ws + OFF_KM);
  const u16* VAT = (const u16*)(p.ws + OFF_VAT); const u16* VMT = (const u16*)(p.ws + OFF_VMT);
  u16* MIXIN = (u16*)(p.ws + OFF_MIXIN);
  const int xq = blockIdx.x & 7, qq = blockIdx.x >> 3, nbx = (int)((gridDim.x - xq + 7) >> 3);
  for (int i = qq; i < 288; i += nbx) {
    if (i < 64) {
      const int bl = xq, h = i >> 4, qb = i & 15;
      const int t0 = TC + bl * 2048 + qb * 128, kr0 = TC + bl * 2304;
      attn_item<96>(QM + (size_t)t0 * 384 + h * 96, 384, KM + (size_t)kr0 * 384 + h * 96, 384,
                    VMT + (size_t)32 * 256 * 256 + (size_t)(bl * 256 + h * 64) * 2304, 2304, MIXIN + (size_t)t0 * HP + 512 + h * 64, smem);
    } else if (i < 192) {
      const int j = i - 64, bl = xq, hq = j >> 4, qb = j & 15, kvh = hq >> 2;
      const int t0 = TC + bl * 2048 + qb * 128, kr0 = TC + bl * 2304;
      attn_item<64>(QA + (size_t)t0 * 512 + hq * 64, 512, KA + (size_t)kr0 * 128 + kvh * 64, 128,
                    VAT + (size_t)32 * 128 * 256 + (size_t)(bl * 128 + kvh * 64) * 2304, 2304, MIXIN + (size_t)t0 * HP + hq * 64, smem);
    } else {
      const int j = i - 192, b = xq * 4 + j / 24, rem = j % 24;
      const int kr0 = b * 256;
      if (rem < 8) {
        const int h = rem >> 1, qb = rem & 1, t0 = b * 256 + qb * 128;
        attn_item<96>(QM + (size_t)t0 * 384 + h * 96, 384, KM + (size_t)kr0 * 384 + h * 96, 384,
                      VMT + (size_t)(b * 256 + h * 64) * 256, 256, MIXIN + (size_t)t0 * HP + 512 + h * 64, smem);
      } else {
        const int rr = rem - 8, hq = rr >> 1, qb = rr & 1, kvh = hq >> 2, t0 = b * 256 + qb * 128;
        attn_item<64>(QA + (size_t)t0 * 512 + hq * 64, 512, KA + (size_t)kr0 * 128 + kvh * 64, 128,
                      VAT + (size_t)(b * 128 + kvh * 64) * 256, 256, MIXIN + (size_t)t0 * HP + hq * 64, smem);
      }
    }
  }
}

DI void g4_phase(const Params& p, int l, char* smem) {
  const u16* W = (const u16*)(p.ws + OFF_WO) + (size_t)l * 1024 * WP;
  const u16* X = (const u16*)(p.ws + OFF_MIXIN);
  float* C = (float*)(p.ws + OFF_MIXOUT);
  const int xq = blockIdx.x & 7, qq = blockIdx.x >> 3, nbx = (int)((gridDim.x - xq + 7) >> 3);
  for (int i = qq; i < 24 * 8; i += nbx) {
    const int tt = (i >> 3) * 8 + xq, nt = i & 7;
    f32x16 acc[2][2];
    gemm_mainloop(W + (size_t)nt * 128 * WP, WP, X + (size_t)tt * 128 * HP, HP, 1024, smem, acc);
    epi_store_f32(acc, C, MP, nt * 128, tt * 128);
  }
}

DI void r2_phase(const Params& p, int l) {
  const int lane = tid_opaque() & 63, w = tid_opaque() >> 6;
  float* MIX = (float*)(p.ws + OFF_MIXOUT);
  u16* H2 = (u16*)(p.ws + OFF_H2);
  const float* lg = p.ln1g + l * 1024; const float* lb = p.ln1b + l * 1024;
  for (int t = blockIdx.x * 4 + w; t < T; t += gridDim.x * 4) {
    const float* xr = (l == 0) ? xin_row(p, t) : (p.out + (size_t)t * 1024);
    const float* m = (const float*)(p.ws + OFF_MOD) + (size_t)(l * 9 + tok_modrow(t)) * 6144;
    float y[16];
#pragma unroll
    for (int i = 0; i < 4; ++i) {
      int c = 4 * (lane + 64 * i);
      f32x4 xv = *(const f32x4*)(xr + c), mv = *(const f32x4*)(MIX + (size_t)t * MP + c), g1 = *(const f32x4*)(m + 2048 + c);
#pragma unroll
      for (int e = 0; e < 4; ++e) y[4 * i + e] = ALPHA * xv[e] + g1[e] * mv[e];
    }
    float mu, rstd; ln_stats16(y, mu, rstd);
#pragma unroll
    for (int i = 0; i < 4; ++i) {
      int c = 4 * (lane + 64 * i);
      f32x4 gv = *(const f32x4*)(lg + c), bv = *(const f32x4*)(lb + c);
      f32x4 o;
#pragma unroll
      for (int e = 0; e < 4; ++e) { y[4 * i + e] = (y[4 * i + e] - mu) * rstd * gv[e] + bv[e]; o[e] = y[4 * i + e]; }
      *(f32x4*)(MIX + (size_t)t * MP + c) = o;
    }
    ln_stats16(y, mu, rstd);
#pragma unroll
    for (int i = 0; i < 4; ++i) {
      int c = 4 * (lane + 64 * i);
      f32x4 sh = *(const f32x4*)(m + 3072 + c), sc = *(const f32x4*)(m + 4096 + c);
      float h[4];
#pragma unroll
      for (int e = 0; e < 4; ++e) h[e] = (y[4 * i + e] - mu) * rstd * (1.f + sc[e]) + sh[e];
      u32x2 o = {pk2(h[0], h[1]), pk2(h[2], h[3])};
      *(u32x2*)(H2 + (size_t)t * HP + c) = o;
    }
  }
}

DI void ce_desc(unsigned& a, unsigned& b) { unsigned mx = a > b ? a : b, mn = a > b ? b : a; a = mx; b = mn; }
DI void sort16_desc(unsigned (&a)[16]) {
#pragma unroll
  for (int k = 2; k <= 16; k <<= 1) {
#pragma unroll
    for (int j = k >> 1; j > 0; j >>= 1) {
#pragma unroll
      for (int i = 0; i < 16; ++i) {
        const int l2 = i ^ j;
        if (l2 > i) { if ((i & k) == 0) ce_desc(a[i], a[l2]); else ce_desc(a[l2], a[i]); }
      }
    }
  }
}
DI void merge16_desc(unsigned (&a)[16]) {
#pragma unroll
  for (int j = 8; j > 0; j >>= 1) {
#pragma unroll
    for (int i = 0; i < 16; ++i) { const int l2 = i ^ j; if (l2 > i) ce_desc(a[i], a[l2]); }
  }
}
DI void top16_merge(unsigned (&a)[16], const unsigned (&b)[16]) {
#pragma unroll
  for (int i = 0; i < 16; ++i) a[i] = a[i] > b[15 - i] ? a[i] : b[15 - i];
  merge16_desc(a);
}
DI unsigned score_key(float f, int idx) {
  unsigned u = __float_as_uint(f);
  u ^= (unsigned)((int)u >> 31) | 0x80000000u;
  return (u & ~127u) | (unsigned)(127 - idx);
}
DI float key_val(unsigned k) {
  unsigned u = k & ~127u;
  u = (u & 0x80000000u) ? (u ^ 0x80000000u) : ~u;
  return __uint_as_float(u);
}

DI void g5_phase(const Params& p, int l, char* smem) {
  const int tid = tid_opaque(), lane = tid & 63, w = tid >> 6, wm = w >> 1, wn = w & 1, r = lane & 31, g = lane >> 5;
  const u16* W = (const u16*)(p.ws + OFF_PWQ) + (size_t)l * 2048 * WP;
  const u16* X = (const u16*)(p.ws + OFF_H2);
  unsigned* TOPK = (unsigned*)(p.ws + OFF_TOPK);
  char* Qs = smem;
  const int xq = blockIdx.x & 7, qq = blockIdx.x >> 3, nbx = (int)((gridDim.x - xq + 7) >> 3);
  for (int i = qq; i < 24 * 16; i += nbx) {
    const int tt = (i >> 4) * 8 + xq, nt = i & 15;
    f32x16 acc[2][2];
    gemm_mainloop(W + (size_t)nt * 128 * WP, WP, X + (size_t)tt * 128 * HP, HP, 1024, smem, acc);
    __syncthreads();
#pragma unroll
    for (int mi = 0; mi < 2; ++mi)
#pragma unroll
      for (int ni = 0; ni < 2; ++ni)
#pragma unroll
        for (int i = 0; i < 4; ++i) {
          u32x2 o = {pk2(acc[mi][ni][4 * i], acc[mi][ni][4 * i + 1]), pk2(acc[mi][ni][4 * i + 2], acc[mi][ni][4 * i + 3])};
          *(u32x2*)(Qs + (64 * wn + 32 * ni + r) * 272 + (64 * wm + 32 * mi + 8 * i + 4 * g) * 2) = o;
        }
    __syncthreads();
    const int h = nt >> 1, half = nt & 1;
    const u16* PK = (const u16*)(p.ws + OFF_PK) + (size_t)(l * 2 + half) * 16384;
    unsigned z[16], y[16];
#pragma unroll
    for (int i = 0; i < 16; ++i) z[i] = 0u;
    bf16x8 qfr[8];
#pragma unroll
    for (int ks = 0; ks < 8; ++ks) qfr[ks] = *(const bf16x8*)(Qs + (32 * w + r) * 272 + (16 * ks + 8 * g) * 2);
#pragma unroll 1
    for (int mt = 0; mt < 4; ++mt) {
      f32x16 sc;
#pragma unroll
      for (int i = 0; i < 16; ++i) sc[i] = 0.f;
#pragma unroll
      for (int ks = 0; ks < 8; ++ks) {
        bf16x8 a = *(const bf16x8*)(PK + (size_t)(32 * mt + r) * 128 + 16 * ks + 8 * g);
        sc = MFMA32(a, qfr[ks], sc);
      }
#pragma unroll
      for (int i = 0; i < 16; ++i) y[i] = score_key(sc[i], 32 * mt + 8 * (i >> 2) + 4 * g + (i & 3));
      sort16_desc(y);
      top16_merge(z, y);
    }
#pragma unroll
    for (int i = 0; i < 16; ++i) y[15 - i] = (unsigned)__shfl_xor((int)z[i], 32);
#pragma unroll
    for (int i = 0; i < 16; ++i) z[i] = z[i] > y[i] ? z[i] : y[i];
    merge16_desc(z);
    if (g == 0) {
      const int t = tt * 128 + 32 * w + r;
      unsigned* dst = TOPK + ((size_t)(t * 8 + h) * 2 + half) * 16;
#pragma unroll
      for (int i = 0; i < 4; ++i) { u32x4 o = {z[4 * i], z[4 * i + 1], z[4 * i + 2], z[4 * i + 3]}; *(u32x4*)(dst + 4 * i) = o; }
    }
  }
}

DI constexpr int sel_pi(int m) { return m < 16 ? 0 : m < 24 ? 1 : m < 29 ? 2 : m < 33 ? 3 : m < 36 ? 4 : m < 38 ? 5 : m < 40 ? 6 : m < 42 ? 7 : m < 50 ? m - 34 : 0; }
DI constexpr int sel_pj(int m) { return m < 16 ? m : m < 24 ? m - 16 : m < 29 ? m - 24 : m < 33 ? m - 29 : m < 36 ? m - 33 : m < 38 ? m - 36 : m < 40 ? m - 38 : m < 42 ? m - 40 : 0; }
DI unsigned sum_key(float f, int m) {
  unsigned u = __float_as_uint(f);
  u ^= (unsigned)((int)u >> 31) | 0x80000000u;
  return (u & ~63u) | (unsigned)(63 - m);
}
DI float sum_key_val(unsigned k) {
  unsigned u = k & ~63u;
  u = (u & 0x80000000u) ? (u ^ 0x80000000u) : ~u;
  return __uint_as_float(u);
}
DI void sel_phase(const Params& p, int l, char* smem) {
  const int tid = tid_opaque();
  unsigned char* s_tab = (unsigned char*)smem;
  unsigned char* s_ii = (unsigned char*)smem + 256 + tid * 32;
  __syncthreads();
  if (tid < 64) { s_tab[2 * tid] = (unsigned char)sel_pi(tid); s_tab[2 * tid + 1] = (unsigned char)sel_pj(tid); }
  __syncthreads();
  const unsigned* TOPK = (const unsigned*)(p.ws + OFF_TOPK);
  const float* SU = (const float*)(p.ws + OFF_SU) + l * 16384;
  const float* SV = (const float*)(p.ws + OFF_SV) + l * 16384;
  int* SIDX = (int*)(p.ws + OFF_SIDX); float* SW = (float*)(p.ws + OFF_SW); float* SSU = (float*)(p.ws + OFF_SSU);
  for (int item = blockIdx.x * 256 + tid; item < T * 8; item += gridDim.x * 256) {
    const unsigned* tk = TOPK + (size_t)item * 32;
    float v1[16], v2[16];
#pragma unroll
    for (int q = 0; q < 4; ++q) {
      const u32x4 a = *(const u32x4*)(tk + 4 * q), b = *(const u32x4*)(tk + 16 + 4 * q);
#pragma unroll
      for (int e = 0; e < 4; ++e) {
        v1[4 * q + e] = key_val(a[e]); s_ii[4 * q + e] = (unsigned char)(127u - (a[e] & 127u));
        v2[4 * q + e] = key_val(b[e]); s_ii[16 + 4 * q + e] = (unsigned char)(127u - (b[e] & 127u));
      }
    }
    unsigned z[16], y[16];
#pragma unroll
    for (int i = 0; i < 16; ++i) z[i] = sum_key(v1[sel_pi(i)] + v2[sel_pj(i)], i);
    sort16_desc(z);
#pragma unroll
    for (int gq = 1; gq < 4; ++gq) {
#pragma unroll
      for (int i = 0; i < 16; ++i) { const int m = 16 * gq + i; y[i] = (m < 50) ? sum_key(v1[sel_pi(m)] + v2[sel_pj(m)], m) : 0u; }
      sort16_desc(y);
      top16_merge(z, y);
    }
    const float mx = sum_key_val(z[0]);
    float ev[16], sum = 0.f;
#pragma unroll
    for (int r = 0; r < 16; ++r) { ev[r] = __expf(sum_key_val(z[r]) - mx); sum += ev[r]; }
    const float inv = 1.f / sum;
    int id[16];
#pragma unroll
    for (int r = 0; r < 16; ++r) {
      const int m = 63 - (int)(z[r] & 63u);
      const int ci = s_tab[2 * m], cj = s_tab[2 * m + 1];
      id[r] = (int)s_ii[ci] * 128 + (int)s_ii[16 + cj];
    }
#pragma unroll
    for (int q = 0; q < 4; ++q) {
      u32x4 oi; f32x4 ow, os;
#pragma unroll
      for (int e = 0; e < 4; ++e) { const int r = 4 * q + e; oi[e] = (unsigned)id[r]; ow[e] = ev[r] * inv * SV[id[r]]; os[e] = SU[id[r]]; }
      *(u32x4*)(SIDX + (size_t)item * 16 + 4 * q) = oi;
      *(f32x4*)(SW + (size_t)item * 16 + 4 * q) = ow;
      *(f32x4*)(SSU + (size_t)item * 16 + 4 * q) = os;
    }
  }
}

#ifndef VRING
#define VRING 16
#endif
#define MFMA8(a, b, c) __builtin_amdgcn_mfma_f32_16x16x32_fp8_fp8((a), (b), (c), 0, 0, 0)
DI long mk64(unsigned lo, unsigned hi) { return (long)(((unsigned long)hi << 32) | (unsigned long)lo); }
DI void e_phase(const Params& p, int l, char* smem) {
  const int tid = tid_opaque(), lane = tid & 63, w = tid >> 6;
  char* xh = smem + w * 2048;
  char* xl = xh + 1024;
  int* s_idx = (int*)(smem + 8192) + w * 128;
  float* s_w = (float*)(smem + 8192 + 2048) + w * 128;
  float* s_su = (float*)(smem + 8192 + 4096) + w * 128;
  const u16* H2 = (const u16*)(p.ws + OFF_H2);
  const int* SIDX = (const int*)(p.ws + OFF_SIDX); const float* SW = (const float*)(p.ws + OFF_SW); const float* SSU = (const float*)(p.ws + OFF_SSU);
  const unsigned char* PU = (const unsigned char*)(p.ws + OFF_PU) + (size_t)l * 16384 * 512;
  const unsigned char* PV = (const unsigned char*)(p.ws + OFF_PV) + (size_t)l * 16384 * 512;
  const float* SU = (const float*)(p.ws + OFF_SU) + l * 16384;
  const float* SV = (const float*)(p.ws + OFF_SV) + l * 16384;
  const float* X1 = (const float*)(p.ws + OFF_MIXOUT);
  u16* H = (u16*)(p.ws + OFF_H);
  const float* lg = p.ln2g + l * 1024; const float* lb = p.ln2b + l * 1024;
  int ci, cj;
  {
    const int c = lane;
    if (c < 16) { ci = 0; cj = c; } else if (c < 24) { ci = 1; cj = c - 16; } else if (c < 29) { ci = 2; cj = c - 24; }
    else if (c < 33) { ci = 3; cj = c - 29; } else if (c < 36) { ci = 4; cj = c - 33; } else if (c < 38) { ci = 5; cj = c - 36; }
    else if (c < 40) { ci = 6; cj = c - 38; } else if (c < 42) { ci = 7; cj = c - 40; } else if (c < 50) { ci = c - 34; cj = 0; }
    else { ci = 0; cj = 0; }
  }
  const bool cand_ok = lane < 50;
  const int r16 = lane & 15, kq = lane >> 4;
  for (int t = blockIdx.x * 4 + w; t < T; t += gridDim.x * 4) {
    const int l32 = lane & 31, half = lane >> 5;
    f32x2_t xv[16];
    {
      const u16* hp = H2 + (size_t)t * HP + 32 * l32;
#pragma unroll
      for (int q = 0; q < 4; ++q) {
        const u32x4 a = *(const u32x4*)(hp + 8 * q);
#pragma unroll
        for (int i = 0; i < 4; ++i) { xv[4 * q + i][0] = bflo(a[i]); xv[4 * q + i][1] = bfhi(a[i]); }
      }
    }
#pragma unroll
    for (int j = 0; j < 2; ++j) {
      const int e = lane + 64 * j;
      s_idx[e] = SIDX[(size_t)t * 128 + e]; s_w[e] = SW[(size_t)t * 128 + e]; s_su[e] = SSU[(size_t)t * 128 + e];
    }
    __builtin_amdgcn_fence(__ATOMIC_SEQ_CST, "wavefront");
    __builtin_amdgcn_wave_barrier();
    const unsigned rlo = 16u * (unsigned)l32;
    {
      const bool b4 = (lane & 16) != 0, b3 = (lane & 8) != 0, b2 = (lane & 4) != 0;
      const int eloc = 2 * ((b4 ? 4 : 0) + (b3 ? 2 : 0) + (b2 ? 1 : 0)) + half;
      u32x4 ur[8];
#pragma unroll
      for (int pq = 0; pq < 8; ++pq) ur[pq] = *(const u32x4*)(PU + ((unsigned)s_idx[2 * pq + half] * 512u + rlo));
#pragma unroll 1
      for (int g = 0; g < 8; ++g) {
        float part[8];
        const int gn = (g + 1) & 7;
#pragma unroll
        for (int pq = 0; pq < 8; ++pq) {
          const u32x4 v = ur[pq];
          if (g < 7) ur[pq] = *(const u32x4*)(PU + ((unsigned)s_idx[gn * 16 + 2 * pq + half] * 512u + rlo));
          f32x2_t accv = {0.f, 0.f};
#pragma unroll
          for (int q = 0; q < 4; ++q) {
            f32x2_t d0 = __builtin_amdgcn_cvt_scalef32_pk_f32_fp4(v[q], 1.0f, 0), d1 = __builtin_amdgcn_cvt_scalef32_pk_f32_fp4(v[q], 1.0f, 1);
            f32x2_t d2 = __builtin_amdgcn_cvt_scalef32_pk_f32_fp4(v[q], 1.0f, 2), d3 = __builtin_amdgcn_cvt_scalef32_pk_f32_fp4(v[q], 1.0f, 3);
            accv += xv[4 * q] * d0; accv += xv[4 * q + 1] * d1; accv += xv[4 * q + 2] * d2; accv += xv[4 * q + 3] * d3;
          }
          part[pq] = accv[0] + accv[1];
          asm volatile("" : "+v"(part[pq]));
        }
        float p4[4], p2[2];
#pragma unroll
        for (int i = 0; i < 4; ++i) {
          const auto sw = __builtin_amdgcn_permlane16_swap(__float_as_uint(part[i]), __float_as_uint(part[4 + i]), false, false);
          p4[i] = __uint_as_float(sw[0]) + __uint_as_float(sw[1]);
        }
#pragma unroll
        for (int i = 0; i < 2; ++i) { const float mine = b3 ? p4[2 + i] : p4[i], oth = b3 ? p4[i] : p4[2 + i]; p2[i] = mine + DPPF(oth, 0x140); }
        float a1 = (b2 ? p2[1] : p2[0]) + DPPF(b2 ? p2[0] : p2[1], 0x141);
        a1 += DPPF(a1, 0x4E); a1 += DPPF(a1, 0xB1);
        const int e = g * 16 + eloc;
        const float wvv = s_w[e] * gelu_tanh(s_su[e] * a1);
        __builtin_amdgcn_fence(__ATOMIC_SEQ_CST, "wavefront");
        __builtin_amdgcn_wave_barrier();
        if ((lane & 3) == 0) s_w[e] = wvv;
      }
    }
    __builtin_amdgcn_fence(__ATOMIC_SEQ_CST, "wavefront");
    __builtin_amdgcn_wave_barrier();
    float ff[16];
    {
      f32x2_t fv[16];
#pragma unroll
      for (int i = 0; i < 16; ++i) { fv[i][0] = 0.f; fv[i][1] = 0.f; }
      u32x4 vr[8];
#pragma unroll
      for (int j = 0; j < 8; ++j) vr[j] = *(const u32x4*)(PV + ((unsigned)s_idx[2 * j + half] * 512u + rlo));
#pragma unroll 1
      for (int p0 = 0; p0 < 64; p0 += 8) {
        const int pn = (p0 + 8) & 63;
#pragma unroll
        for (int j = 0; j < 8; ++j) {
          const u32x4 v = vr[j];
          vr[j] = *(const u32x4*)(PV + ((unsigned)s_idx[2 * (pn + j) + half] * 512u + rlo));
          const float we = s_w[2 * (p0 + j) + half];
          const f32x2_t we2 = {we, we};
#pragma unroll
          for (int q = 0; q < 4; ++q) {
            f32x2_t d0 = __builtin_amdgcn_cvt_scalef32_pk_f32_fp4(v[q], 1.0f, 0), d1 = __builtin_amdgcn_cvt_scalef32_pk_f32_fp4(v[q], 1.0f, 1);
            f32x2_t d2 = __builtin_amdgcn_cvt_scalef32_pk_f32_fp4(v[q], 1.0f, 2), d3 = __builtin_amdgcn_cvt_scalef32_pk_f32_fp4(v[q], 1.0f, 3);
            fv[4 * q] += we2 * d0; fv[4 * q + 1] += we2 * d1; fv[4 * q + 2] += we2 * d2; fv[4 * q + 3] += we2 * d3;
          }
          asm volatile("" : "+v"(fv[0]), "+v"(fv[1]), "+v"(fv[2]), "+v"(fv[3]), "+v"(fv[4]), "+v"(fv[5]), "+v"(fv[6]), "+v"(fv[7]),
                            "+v"(fv[8]), "+v"(fv[9]), "+v"(fv[10]), "+v"(fv[11]), "+v"(fv[12]), "+v"(fv[13]), "+v"(fv[14]), "+v"(fv[15]));
        }
      }
#pragma unroll
      for (int i = 0; i < 8; ++i) {
        const auto s0 = __builtin_amdgcn_permlane32_swap(__float_as_uint(fv[i][0]), __float_as_uint(fv[8 + i][0]), false, false);
        const auto s1 = __builtin_amdgcn_permlane32_swap(__float_as_uint(fv[i][1]), __float_as_uint(fv[8 + i][1]), false, false);
        ff[2 * i] = __uint_as_float(s0[0]) + __uint_as_float(s0[1]);
        ff[2 * i + 1] = __uint_as_float(s1[0]) + __uint_as_float(s1[1]);
      }
    }
    const int cb = 32 * l32 + 16 * half;
    __builtin_amdgcn_fence(__ATOMIC_SEQ_CST, "wavefront");
    __builtin_amdgcn_wave_barrier();
    const float* m = (const float*)(p.ws + OFF_MOD) + (size_t)(l * 9 + tok_modrow(t)) * 6144;
    float y[16];
#pragma unroll
    for (int q = 0; q < 4; ++q) {
      const int c = cb + 4 * q;
      f32x4 xv = *(const f32x4*)(X1 + (size_t)t * MP + c), g2 = *(const f32x4*)(m + 5120 + c);
#pragma unroll
      for (int e = 0; e < 4; ++e) y[4 * q + e] = ALPHA * xv[e] + g2[e] * ff[4 * q + e];
    }
    float mu, rstd; ln_stats16(y, mu, rstd);
#pragma unroll
    for (int q = 0; q < 4; ++q) {
      const int c = cb + 4 * q;
      f32x4 gv = *(const f32x4*)(lg + c), bv = *(const f32x4*)(lb + c), o;
#pragma unroll
      for (int e = 0; e < 4; ++e) { float v = (y[4 * q + e] - mu) * rstd * gv[e] + bv[e]; y[4 * q + e] = v; o[e] = v; }
      *(f32x4*)(p.out + (size_t)t * 1024 + c) = o;
    }
    if (l == 0) {
      const float* m1 = (const float*)(p.ws + OFF_MOD) + (size_t)(9 + tok_modrow(t)) * 6144;
      ln_stats16(y, mu, rstd);
#pragma unroll
      for (int hh = 0; hh < 2; ++hh) {
        const int c = cb + 8 * hh;
        f32x4 sh0 = *(const f32x4*)(m1 + c), sh1 = *(const f32x4*)(m1 + c + 4), sc0 = *(const f32x4*)(m1 + 1024 + c), sc1 = *(const f32x4*)(m1 + 1024 + c + 4);
        float hv[8];
#pragma unroll
        for (int e = 0; e < 4; ++e) {
          hv[e] = (y[8 * hh + e] - mu) * rstd * (1.f + sc0[e]) + sh0[e];
          hv[4 + e] = (y[8 * hh + 4 + e] - mu) * rstd * (1.f + sc1[e]) + sh1[e];
        }
        u32x4 o = {pk2(hv[0], hv[1]), pk2(hv[2], hv[3]), pk2(hv[4], hv[5]), pk2(hv[6], hv[7])};
        *(u32x4*)(H + (size_t)t * HP + c) = o;
      }
    }
  }
}

#define XB_TMO      128
#define XB_XCNT(j)  (256  + 64 * (j))
#define XB_XSUB(j)  (1280 + 64 * (j))
#define XB_XGEN(j)  (2304 + 64 * (j))
#define XB_TOP      3328
#define XB_TOPGEN   3392
#define XCD_BAR_WORDS 3456
#define XB_SPIN_CAP (1u << 18)
#define LAS __attribute__((address_space(3)))
__device__ __forceinline__ unsigned xb_ld(unsigned* p)              { return __hip_atomic_load(p, __ATOMIC_RELAXED, __HIP_MEMORY_SCOPE_AGENT); }
__device__ __forceinline__ unsigned xb_add(unsigned* p, unsigned v) { return __hip_atomic_fetch_add(p, v, __ATOMIC_RELAXED, __HIP_MEMORY_SCOPE_AGENT); }
__device__ __forceinline__ unsigned xb_xcc_id() { return (unsigned)__builtin_amdgcn_s_getreg((3 << 11) | 20) & 0xFu; }
#define XB_SPIN(cond, bar) do { unsigned _sp = 0; while (cond) { __builtin_amdgcn_s_sleep(1); \
    if ((++_sp & 255u) == 0u) { if (xb_ld(&(bar)[XB_TMO])) break; if (_sp > XB_SPIN_CAP) { atomicAdd(&(bar)[XB_TMO], 1u); break; } } } } while (0)
struct XcdBarrier { unsigned* bar; unsigned x; volatile LAS unsigned* st; };
__device__ __forceinline__ XcdBarrier xcd_barrier_post(unsigned* bar, volatile LAS unsigned* st) {
    XcdBarrier b; b.bar = bar; b.x = xb_xcc_id(); b.st = st;
    if (threadIdx.x == 0) (void)xb_add(&bar[XB_XCNT(b.x)], 1u);
    return b;
}
__device__ __forceinline__ void xcd_barrier_complete(unsigned* bar, unsigned x, unsigned& nloc, unsigned& nx) {
    const unsigned G = gridDim.x * gridDim.y * gridDim.z;
    unsigned sum, cnt, mine, sp = 0u;
    for (;;) {
        sum = 0u; cnt = 0u; mine = 0u;
#pragma unroll
        for (unsigned j = 0; j < 16; ++j) { const unsigned c = xb_ld(&bar[XB_XCNT(j)]); sum += c; cnt += (c > 0u) ? 1u : 0u; mine = (j == x) ? c : mine; }
        if (sum == G) break;
        __builtin_amdgcn_s_sleep(1);
        if ((++sp & 255u) == 0u) { if (xb_ld(&bar[XB_TMO])) break; if (sp > XB_SPIN_CAP) { atomicAdd(&bar[XB_TMO], 1u); break; } }
    }
    nloc = mine > 0u ? mine : 1u; nx = cnt > 0u ? cnt : 1u;
}
__device__ __forceinline__ void xcd_barrier(const XcdBarrier& b) {
    asm volatile("s_waitcnt vmcnt(0)" ::: "memory");
    __syncthreads();
    if (threadIdx.x == 0) {
        unsigned* bar = b.bar;
        __builtin_amdgcn_s_waitcnt(0);
        unsigned nloc = b.st[0], nx = b.st[1];
        if (nloc == 0u) { xcd_barrier_complete(bar, b.x, nloc, nx); b.st[0] = nloc; b.st[1] = nx; }
        const unsigned old = xb_add(&bar[XB_XSUB(b.x)], 1u);
        const unsigned gen = old / nloc;
        if (old + 1u == (gen + 1u) * nloc) {
            __builtin_amdgcn_fence(__ATOMIC_RELEASE, "agent");
            asm volatile("s_waitcnt vmcnt(0)" ::: "memory");
            const unsigned og = xb_add(&bar[XB_TOP], 1u);
            const unsigned tg = og / nx;
            if (og + 1u == (tg + 1u) * nx) xb_add(&bar[XB_TOPGEN], 1u);
            else XB_SPIN(xb_ld(&bar[XB_TOPGEN]) == tg, bar);
            __builtin_amdgcn_fence(__ATOMIC_ACQUIRE, "agent");
            xb_add(&bar[XB_XGEN(b.x)], 1u);
            asm volatile("s_waitcnt vmcnt(0)" ::: "memory");
        } else {
            XB_SPIN(xb_ld(&bar[XB_XGEN(b.x)]) == gen, bar);
            __builtin_amdgcn_fence(__ATOMIC_ACQUIRE, "agent");
            asm volatile("s_waitcnt vmcnt(0)" ::: "memory");
        }
    }
    __syncthreads();
}

constexpr int NPHASE = 2 + 2 * 9;
#ifndef PH_MASK
#define PH_MASK 2047
#endif
#ifndef PH_TWICE
#define PH_TWICE 0
#endif
__global__ void __launch_bounds__(256, 3) fwd_megakernel(Params p, int ph_lo, int ph_hi) {
  __shared__ __attribute__((aligned(16))) char smem[SMEM_BYTES];
  cg::grid_group grid = cg::this_grid();
  __shared__ uint4 xb_words;
  if (threadIdx.x == 0) xb_words = make_uint4(0u, 0u, 0u, 0u);
  __syncthreads();
  const XcdBarrier xb = xcd_barrier_post((unsigned*)(p.ws + OFF_BAR), (volatile LAS unsigned*)&xb_words);
  if (ph_lo < 0) grid.sync();
#define RUN_PH(ph, mask, call) { const int ph_ = (ph); if (ph_ >= ph_lo && ph_ < ph_hi) { if (ph_ > ph_lo) xcd_barrier(xb); if (PH_MASK & (mask)) { call; } if (PH_TWICE & (mask)) { xcd_barrier(xb); call; } } }
  RUN_PH(0, 1, prep_phase(p, smem));
  RUN_PH(1, 2, s0_phase(p));
  for (int l = 0; l < 2; ++l) {
    const int b = 2 + 9 * l;
    RUN_PH(b + 0, 4, g1_phase(p, l, smem));
    RUN_PH(b + 1, 8, r1_phase(p, l, smem));
    RUN_PH(b + 2, 16, mid_phase(p, l, smem));
    RUN_PH(b + 3, 32, attn_phase(p, smem));
    RUN_PH(b + 4, 64, g4_phase(p, l, smem));
    RUN_PH(b + 5, 128, r2_phase(p, l));
    RUN_PH(b + 6, 256, g5_phase(p, l, smem));
    RUN_PH(b + 7, 1024, sel_phase(p, l, smem));
    RUN_PH(b + 8, 512, e_phase(p, l, smem));
  }
}

#ifndef MULTI_LAUNCH
#define MULTI_LAUNCH 0
#endif

extern "C" void kernel_launch(void* const* d_in, const int* in_sizes, int n_in, void* d_out, int out_size, void* d_ws, size_t ws_size,
                              hipStream_t stream) {
  (void)in_sizes; (void)n_in; (void)out_size;
  if (ws_size < WS_NEED) { fprintf(stderr, "workspace too small: %zu < %zu\n", ws_size, (size_t)WS_NEED); return; }
  Params p{};
  const float** pp = (const float**)&p;
  for (int i = 0; i < 29; ++i) pp[i] = (const float*)d_in[i];
  p.out = (float*)d_out; p.ws = (char*)d_ws;
  static int grid_blocks = 0;
  if (!grid_blocks) {
    int dev = 0, cus = 0, per_cu = 0;
    hipGetDevice(&dev);
    hipDeviceGetAttribute(&cus, hipDeviceAttributeMultiprocessorCount, dev);
    hipOccupancyMaxActiveBlocksPerMultiprocessor(&per_cu, fwd_megakernel, 256, 0);
    if (per_cu < 1) per_cu = 1;
    grid_blocks = cus * per_cu;
  }
  hipMemsetAsync((char*)d_ws + OFF_MOD, 0, SZ_MOD + SZ_BAR, stream);
#if MULTI_LAUNCH
  for (int ph = 0; ph < NPHASE; ++ph) {
    int lo = ph, hi = ph + 1;
    hipLaunchKernelGGL(fwd_megakernel, dim3(grid_blocks), dim3(256), 0, stream, p, lo, hi);
  }
#else
  int lo = 0, hi = NPHASE;
  void* args[] = {&p, &lo, &hi};
  hipError_t e = hipLaunchCooperativeKernel((void*)fwd_megakernel, dim3(grid_blocks), dim3(256), args, 0, stream);
  if (e != hipSuccess) fprintf(stderr, "cooperative launch failed: %s (grid %d)\n", hipGetErrorString(e), grid_blocks);
#endif
}
```

```cpp
#include <hip/hip_runtime.h>
#include <hip/hip_cooperative_groups.h>
#include <cstdio>
#include <cstdint>
namespace cg = cooperative_groups;

typedef unsigned short u16;
typedef __bf16 bf16x2_t __attribute__((ext_vector_type(2)));
typedef float f32x2_t __attribute__((ext_vector_type(2)));
using bf16x8 = __attribute__((ext_vector_type(8))) short;
using f32x16 = __attribute__((ext_vector_type(16))) float;
using f32x4 = __attribute__((ext_vector_type(4))) float;
using u32x4 = __attribute__((ext_vector_type(4))) unsigned;
using u32x2 = __attribute__((ext_vector_type(2))) unsigned;
#define DI __device__ __forceinline__
#define MFMA32(a, b, c) __builtin_amdgcn_mfma_f32_32x32x16_bf16((a), (b), (c), 0, 0, 0)
#define MFMA16(a, b, c) __builtin_amdgcn_mfma_f32_16x16x32_bf16((a), (b), (c), 0, 0, 0)

constexpr int T = 24576, TC = 8192, NK = 26624, PLD = 1792;
constexpr int HP = 1088;
constexpr int WP = 1088;
constexpr int MP = 1056;
constexpr float LOG2E = 1.4426950408889634f;
constexpr float ALPHA = 1.4142135623730951f;
constexpr float EPS = 1e-6f;

struct Params {
  const float* x_prompt; const float* x_sample; const float* cache_k; const float* cache_v; const float* cache_ckv; const float* cache_kr;
  const float* c; const float* c_ctx; const float* w_mod; const float* b_mod; const float* w_in; const float* aqn; const float* akn;
  const float* mqn; const float* mkvn; const float* w_uq; const float* w_ukv; const float* gws; const float* gb; const float* w_o;
  const float* ln1g; const float* ln1b; const float* ln2g; const float* ln2b; const float* pwq; const float* pk1; const float* pk2;
  const float* pu; const float* pv;
  float* out; char* ws;
};

constexpr size_t al(size_t x) { return (x + 255) & ~(size_t)255; }
constexpr size_t OFF_MOD = 0;                        constexpr size_t SZ_MOD = (size_t)2 * 9 * 6144 * 4;
constexpr size_t OFF_BAR = OFF_MOD + SZ_MOD;          constexpr size_t SZ_BAR = (size_t)3456 * 4;
constexpr size_t OFF_R16 = al(OFF_BAR + SZ_BAR);
constexpr size_t OFF_R8 = al(OFF_R16 + 64 * 16 * 2 * 4);
constexpr size_t OFF_WIN = al(OFF_R8 + 64 * 8 * 2 * 4);
constexpr size_t OFF_WUQ = al(OFF_WIN + (size_t)2 * 1792 * WP * 2);
constexpr size_t OFF_WUKV = al(OFF_WUQ + (size_t)2 * 384 * 256 * 2);
constexpr size_t OFF_WO = al(OFF_WUKV + (size_t)2 * 512 * 128 * 2);
constexpr size_t OFF_PWQ = al(OFF_WO + (size_t)2 * 1024 * WP * 2);
constexpr size_t OFF_PK = al(OFF_PWQ + (size_t)2 * 2048 * WP * 2);
constexpr size_t OFF_GWS = al(OFF_PK + (size_t)2 * 2 * 128 * 128 * 2);
constexpr size_t OFF_PU = al(OFF_GWS + (size_t)2 * 4 * 128 * 128 * 2);
constexpr size_t OFF_PV = al(OFF_PU + (size_t)2 * 16384 * 1024);
constexpr size_t OFF_SU = al(OFF_PV + (size_t)2 * 16384 * 1024);
constexpr size_t OFF_SV = al(OFF_SU + (size_t)2 * 16384 * 4);
constexpr size_t OFF_H = al(OFF_SV + (size_t)2 * 16384 * 4);
constexpr size_t OFF_PROJ = al(OFF_H + (size_t)T * HP * 2);
constexpr size_t OFF_MIXOUT = OFF_PROJ;
constexpr size_t OFF_MIXIN = OFF_PROJ + (size_t)T * MP * 4;
constexpr size_t OFF_ATT = al(OFF_PROJ + (size_t)T * PLD * 4);
constexpr size_t OFF_QA = OFF_ATT;
constexpr size_t OFF_CQ = OFF_QA + (size_t)T * 512 * 2;
constexpr size_t OFF_UC = OFF_CQ + (size_t)T * 256 * 2;
constexpr size_t OFF_VGT = OFF_UC + (size_t)T * 256 * 2;
constexpr size_t OFF_QM = OFF_VGT + (size_t)T * 256 * 2;
constexpr size_t OFF_KA = OFF_QM + (size_t)T * 384 * 2;
constexpr size_t OFF_VAT = OFF_KA + (size_t)NK * 128 * 2;
constexpr size_t OFF_CKV = OFF_VAT + (size_t)NK * 128 * 2;
constexpr size_t OFF_KM = OFF_CKV + (size_t)NK * 128 * 2;
constexpr size_t OFF_VMT = OFF_KM + (size_t)NK * 384 * 2;
constexpr size_t OFF_ATT_END = OFF_VMT + (size_t)NK * 256 * 2;
constexpr size_t OFF_H2 = OFF_ATT;
constexpr size_t OFF_TOPK = OFF_ATT + (size_t)T * HP * 2;
constexpr size_t OFF_SIDX = OFF_TOPK + (size_t)T * 256 * 4;
constexpr size_t OFF_SW = OFF_SIDX + (size_t)T * 128 * 4;
constexpr size_t OFF_SSU = OFF_SW + (size_t)T * 128 * 4;
static_assert(OFF_SSU + (size_t)T * 128 * 4 <= OFF_ATT_END, "alias overflow 3");
constexpr size_t WS_NEED = OFF_ATT_END;
static_assert(OFF_TOPK + (size_t)T * 256 * 4 <= OFF_ATT_END, "alias overflow");
static_assert(OFF_MIXIN + (size_t)T * HP * 2 <= OFF_ATT, "alias overflow 2");

constexpr size_t OUT_K = (size_t)T * 1024;
constexpr size_t OUT_V = OUT_K + 2097152;
constexpr size_t OUT_CKV = OUT_V + 2097152;
constexpr size_t OUT_KR = OUT_CKV + 2097152;

constexpr int SMEM_BYTES = 36864;

DI int tid_opaque() { int t = threadIdx.x; asm volatile("" : "+v"(t)); return t; }
DI unsigned pk2(float a, float b) { f32x2_t v = {a, b}; bf16x2_t r = __builtin_convertvector(v, bf16x2_t); return __builtin_bit_cast(unsigned, r); }
DI float bflo(unsigned u) { return __uint_as_float(u << 16); }
DI float bfhi(unsigned u) { return __uint_as_float(u & 0xffff0000u); }
#define DPPF(v, ctrl) __int_as_float(__builtin_amdgcn_update_dpp(0, __float_as_int(v), (ctrl), 0xF, 0xF, false))
DI float wave_sum(float v) {
  v += DPPF(v, 0xB1);
  v += DPPF(v, 0x4E);
  v += DPPF(v, 0x124);
  v += DPPF(v, 0x128);
  { const auto s16 = __builtin_amdgcn_permlane16_swap(__float_as_uint(v), __float_as_uint(v), false, false); v = __uint_as_float(s16[0]) + __uint_as_float(s16[1]); }
  { const auto s32 = __builtin_amdgcn_permlane32_swap(__float_as_uint(v), __float_as_uint(v), false, false); v = __uint_as_float(s32[0]) + __uint_as_float(s32[1]); }
  return v;
}
DI float wave_max(float v) {
  v = fmaxf(v, DPPF(v, 0xB1));
  v = fmaxf(v, DPPF(v, 0x4E));
  v = fmaxf(v, DPPF(v, 0x124));
  v = fmaxf(v, DPPF(v, 0x128));
  { const auto s16 = __builtin_amdgcn_permlane16_swap(__float_as_uint(v), __float_as_uint(v), false, false); v = fmaxf(__uint_as_float(s16[0]), __uint_as_float(s16[1])); }
  { const auto s32 = __builtin_amdgcn_permlane32_swap(__float_as_uint(v), __float_as_uint(v), false, false); v = fmaxf(__uint_as_float(s32[0]), __uint_as_float(s32[1])); }
  return v;
}
DI const float* xin_row(const Params& p, int t) { return t < TC ? p.x_prompt + (size_t)t * 1024 : p.x_sample + (size_t)(t - TC) * 1024; }
DI int tok_modrow(int t) { return t < TC ? 0 : 1 + ((t - TC) >> 11); }
DI int tok_keyrow(int t) { if (t < TC) return t; int u = t - TC; return TC + (u >> 11) * 2304 + 256 + (u & 2047); }
DI size_t vt_index(int kr, int ch, int C) {
  if (kr < TC) return ((size_t)((kr >> 8) * C + ch)) * 256 + (kr & 255);
  int u = kr - TC; int bl = u / 2304; int pos = u - bl * 2304;
  return (size_t)32 * C * 256 + ((size_t)(bl * C + ch)) * 2304 + pos;
}
DI float gelu_tanh(float x) {
  float u = 0.7978845608028654f * (x + 0.044715f * x * x * x);
  float e = __expf(2.f * u);
  float th = 1.f - 2.f * __builtin_amdgcn_rcpf(e + 1.f);
  return 0.5f * x * (1.f + th);
}

DI void ln_stats16(const float (&x)[16], float& mu, float& rstd) {
  float s = 0.f;
#pragma unroll
  for (int i = 0; i < 16; ++i) s += x[i];
  s = wave_sum(s); mu = s * (1.f / 1024.f);
  float q = 0.f;
#pragma unroll
  for (int i = 0; i < 16; ++i) { float d = x[i] - mu; q += d * d; }
  q = wave_sum(q);
  rstd = rsqrtf(q * (1.f / 1024.f) + EPS);
}

DI void transpose_tile(const float* __restrict__ src, int N, u16* __restrict__ dst, int ldd, int k0, int n0, char* smem) {
  float* s = (float*)smem;
  const int tid = tid_opaque();
  __syncthreads();
#pragma unroll
  for (int it = 0; it < 4; ++it) {
    int kk = (tid >> 4) + 16 * it, cn = (tid & 15) * 4;
    f32x4 v = {0.f, 0.f, 0.f, 0.f};
    if (n0 + cn < N) v = *(const f32x4*)(src + (size_t)(k0 + kk) * N + n0 + cn);
    s[kk * 65 + cn + 0] = v[0]; s[kk * 65 + cn + 1] = v[1]; s[kk * 65 + cn + 2] = v[2]; s[kk * 65 + cn + 3] = v[3];
  }
  __syncthreads();
#pragma unroll
  for (int it = 0; it < 2; ++it) {
    int id = tid + 256 * it, n = id >> 3, kc = id & 7;
    if (n0 + n < N) {
      u32x4 o;
#pragma unroll
      for (int e = 0; e < 4; ++e) o[e] = pk2(s[(kc * 8 + 2 * e) * 65 + n], s[(kc * 8 + 2 * e + 1) * 65 + n]);
      *(u32x4*)(dst + (size_t)(n0 + n) * ldd + k0 + kc * 8) = o;
    }
  }
}

DI void convert_task(const float* __restrict__ src, u16* __restrict__ dst, size_t base) {
  const int tid = tid_opaque();
#pragma unroll
  for (int it = 0; it < 2; ++it) {
    size_t i = base + (size_t)(it * 256 + tid) * 8;
    f32x4 a = *(const f32x4*)(src + i), b = *(const f32x4*)(src + i + 4);
    u32x4 o = {pk2(a[0], a[1]), pk2(a[2], a[3]), pk2(b[0], b[1]), pk2(b[2], b[3])};
    *(u32x4*)(dst + i) = o;
  }
}

DI void quant_rows_task(const float* __restrict__ src, unsigned char* __restrict__ dst, float* __restrict__ scl, int row0) {
  const int tid = tid_opaque(), lane = tid & 63, w = tid >> 6;
#pragma unroll 2
  for (int q = 0; q < 8; ++q) {
    const int row = row0 + w * 8 + q;
    const float* sp = src + (size_t)row * 1024 + lane * 16;
    f32x4 v[4];
    float am = 0.f;
#pragma unroll
    for (int i = 0; i < 4; ++i) { v[i] = *(const f32x4*)(sp + 4 * i); am = fmaxf(am, fmaxf(fmaxf(fabsf(v[i][0]), fabsf(v[i][1])), fmaxf(fabsf(v[i][2]), fabsf(v[i][3])))); }
    am = wave_max(am);
    const float sc = am > 0.f ? am * (1.f / 400.f) : 1.f;
    const float inv = 1.f / sc;
    u32x4 o;
#pragma unroll
    for (int i = 0; i < 4; ++i) {
      int wd = __builtin_amdgcn_cvt_pk_fp8_f32(v[i][0] * inv, v[i][1] * inv, 0, false);
      wd = __builtin_amdgcn_cvt_pk_fp8_f32(v[i][2] * inv, v[i][3] * inv, wd, true);
      o[i] = (unsigned)wd;
    }
    *(u32x4*)(dst + (size_t)row * 1024 + lane * 16) = o;
    if (lane == 0) scl[row] = sc;
  }
}

DI void quant_rows_fp4_task(const float* __restrict__ src, unsigned char* __restrict__ dst, float* __restrict__ scl, int row0) {
  const int tid = tid_opaque(), lane = tid & 63, w = tid >> 6;
#pragma unroll 2
  for (int q = 0; q < 8; ++q) {
    const int row = row0 + w * 8 + q;
    const float* sp = src + (size_t)row * 1024 + lane * 16;
    f32x4 v[4];
    float am = 0.f;
#pragma unroll
    for (int i = 0; i < 4; ++i) { v[i] = *(const f32x4*)(sp + 4 * i); am = fmaxf(am, fmaxf(fmaxf(fabsf(v[i][0]), fabsf(v[i][1])), fmaxf(fabsf(v[i][2]), fabsf(v[i][3])))); }
    am = wave_max(am);
    const float sc = am > 0.f ? am * (1.f / 6.f) : 1.f;
    const float inv = 1.f / sc;
    u32x2 o;
#pragma unroll
    for (int j = 0; j < 2; ++j) {
      unsigned wd = 0u;
      wd = __builtin_amdgcn_cvt_scalef32_pk_fp4_f32(wd, v[2 * j][0] * inv, v[2 * j][1] * inv, 1.0f, 0);
      wd = __builtin_amdgcn_cvt_scalef32_pk_fp4_f32(wd, v[2 * j][2] * inv, v[2 * j][3] * inv, 1.0f, 1);
      wd = __builtin_amdgcn_cvt_scalef32_pk_fp4_f32(wd, v[2 * j + 1][0] * inv, v[2 * j + 1][1] * inv, 1.0f, 2);
      wd = __builtin_amdgcn_cvt_scalef32_pk_fp4_f32(wd, v[2 * j + 1][2] * inv, v[2 * j + 1][3] * inv, 1.0f, 3);
      o[j] = wd;
    }
    *(u32x2*)(dst + (size_t)row * 512 + lane * 8) = o;
    if (lane == 0) scl[row] = sc;
  }
}

DI void prep_phase(const Params& p, char* smem) {
  const int tid = tid_opaque();
  constexpr int N_MOD = 768, N_TR_L = 1240, N_TR = 2 * N_TR_L;
  constexpr int B_TR = N_MOD, B_PK = B_TR + N_TR, B_GWS = B_PK + 16, B_PU = B_GWS + 32, B_PV = B_PU + 1024, B_ZP = B_PV + 1024, B_RT = B_ZP + 2, N_ALL = B_RT + 1;
  for (int task = blockIdx.x; task < N_ALL; task += gridDim.x) {
    if (task < B_TR) {
      const int l = task / 384, rem = task % 384, nc = rem >> 4, kc = rem & 15;
      float* sc = (float*)smem;
      __syncthreads();
      for (int e = tid; e < 576; e += 256) {
        int r = e >> 6, k = e & 63;
        float v = (r == 0) ? p.c_ctx[kc * 64 + k] : p.c[(r - 1) * 1024 + kc * 64 + k];
        sc[e] = v / (1.f + __expf(-v));
      }
      __syncthreads();
      const int n = nc * 256 + tid;
      const float* w = p.w_mod + ((size_t)l * 1024 + kc * 64) * 6144 + n;
      float acc[9];
#pragma unroll
      for (int r = 0; r < 9; ++r) acc[r] = 0.f;
#pragma unroll 8
      for (int k = 0; k < 64; ++k) {
        float wv = w[(size_t)k * 6144];
#pragma unroll
        for (int r = 0; r < 9; ++r) acc[r] += sc[r * 64 + k] * wv;
      }
      float* mod = (float*)(p.ws + OFF_MOD) + (size_t)l * 9 * 6144;
      float bias = (kc == 0) ? p.b_mod[l * 6144 + n] : 0.f;
#pragma unroll
      for (int r = 0; r < 9; ++r) unsafeAtomicAdd(&mod[r * 6144 + n], acc[r] + bias);
    } else if (task < B_PK) {
      int j = task - B_TR; const int l = j / N_TR_L; int r = j % N_TR_L;
      if (r < 432) { int kt = r / 27, nt = r % 27; transpose_tile(p.w_in + (size_t)l * 1024 * 1696, 1696, (u16*)(p.ws + OFF_WIN) + (size_t)l * 1792 * WP, WP, kt * 64, nt * 64, smem); }
      else if (r < 456) { r -= 432; int kt = r / 6, nt = r % 6; transpose_tile(p.w_uq + (size_t)l * 256 * 384, 384, (u16*)(p.ws + OFF_WUQ) + (size_t)l * 384 * 256, 256, kt * 64, nt * 64, smem); }
      else if (r < 472) { r -= 456; int kt = r / 8, nt = r % 8; transpose_tile(p.w_ukv + (size_t)l * 128 * 512, 512, (u16*)(p.ws + OFF_WUKV) + (size_t)l * 512 * 128, 128, kt * 64, nt * 64, smem); }
      else if (r < 728) { r -= 472; int kt = r / 16, nt = r % 16; transpose_tile(p.w_o + (size_t)l * 1024 * 1024, 1024, (u16*)(p.ws + OFF_WO) + (size_t)l * 1024 * WP, WP, kt * 64, nt * 64, smem); }
      else { r -= 728; int kt = r / 32, nt = r % 32; transpose_tile(p.pwq + (size_t)l * 1024 * 2048, 2048, (u16*)(p.ws + OFF_PWQ) + (size_t)l * 2048 * WP, WP, kt * 64, nt * 64, smem); }
    } else if (task < B_GWS) {
      int j = task - B_PK;
      int l = j >> 3, half = (j >> 2) & 1, ch = j & 3;
      const float* src = (half ? p.pk2 : p.pk1) + (size_t)l * 16384;
      convert_task(src, (u16*)(p.ws + OFF_PK) + (size_t)(l * 2 + half) * 16384, (size_t)ch * 4096);
    } else if (task < B_PU) {
      convert_task(p.gws, (u16*)(p.ws + OFF_GWS), (size_t)(task - B_GWS) * 4096);
    } else if (task < B_PV) {
      quant_rows_fp4_task(p.pu, (unsigned char*)(p.ws + OFF_PU), (float*)(p.ws + OFF_SU), (task - B_PU) * 32);
    } else if (task < B_ZP) {
      quant_rows_fp4_task(p.pv, (unsigned char*)(p.ws + OFF_PV), (float*)(p.ws + OFF_SV), (task - B_PV) * 32);
    } else if (task < B_RT) {
      int l = task - B_ZP;
      u16* dst = (u16*)(p.ws + OFF_WIN) + ((size_t)l * 1792 + 1696) * WP;
      u32x4 z = {0u, 0u, 0u, 0u};
      for (int c = tid; c < 96 * WP / 8; c += 256) *(u32x4*)(dst + (size_t)c * 8) = z;
    } else {
      float* r16 = (float*)(p.ws + OFF_R16); float* r8 = (float*)(p.ws + OFF_R8);
      for (int e = tid; e < 1024; e += 256) {
        int pos = e >> 4, f = e & 15;
        float fr = exp2f(-(float)f * (13.287712379549449f / 16.f));
        float ang = (float)pos * fr;
        r16[e * 2] = __cosf(ang); r16[e * 2 + 1] = __sinf(ang);
      }
      for (int e = tid; e < 512; e += 256) {
        int pos = e >> 3, f = e & 7;
        float fr = exp2f(-(float)f * (13.287712379549449f / 8.f));
        float ang = (float)pos * fr;
        r8[e * 2] = __cosf(ang); r8[e * 2 + 1] = __sinf(ang);
      }
    }
  }
}


DI void s0_phase(const Params& p) {
  const int lane = tid_opaque() & 63, w = tid_opaque() >> 6;
  u16* H = (u16*)(p.ws + OFF_H);
  for (int t = blockIdx.x * 4 + w; t < T; t += gridDim.x * 4) {
    const float* xr = xin_row(p, t);
    float x[16];
#pragma unroll
    for (int i = 0; i < 4; ++i) { f32x4 v = *(const f32x4*)(xr + 4 * (lane + 64 * i)); x[4 * i] = v[0]; x[4 * i + 1] = v[1]; x[4 * i + 2] = v[2]; x[4 * i + 3] = v[3]; }
    float mu, rstd; ln_stats16(x, mu, rstd);
    const float* m = (const float*)(p.ws + OFF_MOD) + (size_t)tok_modrow(t) * 6144;
#pragma unroll
    for (int i = 0; i < 4; ++i) {
      int c = 4 * (lane + 64 * i);
      f32x4 sh = *(const f32x4*)(m + c), sc = *(const f32x4*)(m + 1024 + c);
      float h0 = (x[4 * i] - mu) * rstd * (1.f + sc[0]) + sh[0];
      float h1 = (x[4 * i + 1] - mu) * rstd * (1.f + sc[1]) + sh[1];
      float h2 = (x[4 * i + 2] - mu) * rstd * (1.f + sc[2]) + sh[2];
      float h3 = (x[4 * i + 3] - mu) * rstd * (1.f + sc[3]) + sh[3];
      u32x2 o = {pk2(h0, h1), pk2(h2, h3)};
      *(u32x2*)(H + (size_t)t * HP + c) = o;
    }
  }
}

DI void gemm_mainloop(const u16* __restrict__ A, int lda, const u16* __restrict__ B, int ldb, int K, char* smem, f32x16 (&acc)[2][2], int nact = 4) {
  const int tid = tid_opaque(), lane = tid & 63, w = tid >> 6, wm = w >> 1, wn = w & 1, r = lane & 31, g = lane >> 5;
  char* As = smem; char* Bs = smem + 128 * 144;
#pragma unroll
  for (int mi = 0; mi < 2; ++mi)
#pragma unroll
    for (int ni = 0; ni < 2; ++ni)
#pragma unroll
      for (int i = 0; i < 16; ++i) acc[mi][ni][i] = 0.f;
  u32x4 ra[4], rb[4];
  const int lrow = tid >> 3, lkc = tid & 7;
  const u16* ga = A + (size_t)lrow * lda + lkc * 8;
  const u16* gb = B + (size_t)lrow * ldb + lkc * 8;
#pragma unroll
  for (int i = 0; i < 4; ++i) { ra[i] = *(const u32x4*)(ga + (size_t)(32 * i) * lda); rb[i] = *(const u32x4*)(gb + (size_t)(32 * i) * ldb); }
  for (int k0 = 0; k0 < K; k0 += 64) {
    __syncthreads();
#pragma unroll
    for (int i = 0; i < 4; ++i) {
      *(u32x4*)(As + (lrow + 32 * i) * 144 + lkc * 16) = ra[i];
      *(u32x4*)(Bs + (lrow + 32 * i) * 144 + lkc * 16) = rb[i];
    }
    __syncthreads();
    if (k0 + 64 < K) {
#pragma unroll
      for (int i = 0; i < 4; ++i) { ra[i] = *(const u32x4*)(ga + (size_t)(32 * i) * lda + k0 + 64); rb[i] = *(const u32x4*)(gb + (size_t)(32 * i) * ldb + k0 + 64); }
    }
    __builtin_amdgcn_s_setprio(2);
    if (2 * wm + 1 < nact) {
#pragma unroll
      for (int ks = 0; ks < 4; ++ks) {
        bf16x8 af[2], bfr[2];
#pragma unroll
        for (int mi = 0; mi < 2; ++mi) af[mi] = *(const bf16x8*)(As + (64 * wm + 32 * mi + r) * 144 + (16 * ks + 8 * g) * 2);
#pragma unroll
        for (int ni = 0; ni < 2; ++ni) bfr[ni] = *(const bf16x8*)(Bs + (64 * wn + 32 * ni + r) * 144 + (16 * ks + 8 * g) * 2);
#pragma unroll
        for (int mi = 0; mi < 2; ++mi)
#pragma unroll
          for (int ni = 0; ni < 2; ++ni) acc[mi][ni] = MFMA32(af[mi], bfr[ni], acc[mi][ni]);
      }
    } else if (2 * wm < nact) {
#pragma unroll
      for (int ks = 0; ks < 4; ++ks) {
        const bf16x8 af0 = *(const bf16x8*)(As + (64 * wm + r) * 144 + (16 * ks + 8 * g) * 2);
#pragma unroll
        for (int ni = 0; ni < 2; ++ni) {
          const bf16x8 bf0 = *(const bf16x8*)(Bs + (64 * wn + 32 * ni + r) * 144 + (16 * ks + 8 * g) * 2);
          acc[0][ni] = MFMA32(af0, bf0, acc[0][ni]);
        }
      }
    }
    __builtin_amdgcn_s_setprio(0);
  }
}

DI void epi_store_f32(const f32x16 (&acc)[2][2], float* __restrict__ C, int ldc, int n0, int t0) {
  const int lane = tid_opaque() & 63, w = tid_opaque() >> 6, wm = w >> 1, wn = w & 1, r = lane & 31, g = lane >> 5;
#pragma unroll
  for (int mi = 0; mi < 2; ++mi)
#pragma unroll
    for (int ni = 0; ni < 2; ++ni) {
      const int t = t0 + 64 * wn + 32 * ni + r;
#pragma unroll
      for (int i = 0; i < 4; ++i) {
        const int n = n0 + 64 * wm + 32 * mi + 8 * i + 4 * g;
        f32x4 v = {acc[mi][ni][4 * i], acc[mi][ni][4 * i + 1], acc[mi][ni][4 * i + 2], acc[mi][ni][4 * i + 3]};
        *(f32x4*)(C + (size_t)t * ldc + n) = v;
      }
    }
}

DI void g1_phase(const Params& p, int l, char* smem) {
  const u16* W = (const u16*)(p.ws + OFF_WIN) + (size_t)l * 1792 * WP;
  const u16* H = (const u16*)(p.ws + OFF_H);
  float* PROJ = (float*)(p.ws + OFF_PROJ);
  const int xq = blockIdx.x & 7, qq = blockIdx.x >> 3, nbx = (int)((gridDim.x - xq + 7) >> 3);
  for (int i = qq; i < 24 * 14; i += nbx) {
    const int tt = (i / 14) * 8 + xq, nt = i % 14;
    f32x16 acc[2][2];
    gemm_mainloop(W + (size_t)nt * 128 * WP, WP, H + (size_t)tt * 128 * HP, HP, 1024, smem, acc, nt == 13 ? 1 : 4);
    epi_store_f32(acc, PROJ, PLD, nt * 128, tt * 128);
  }
}

DI void rope16_apply(float (&v)[8], int c, int rowp, int colp, const float* __restrict__ r16) {
  const int pos = (c < 4) ? rowp : colp;
  const float* tb = r16 + (size_t)(pos * 16 + (c & 1) * 8) * 2;
  const bool is_x1 = (c & 2) == 0;
#pragma unroll
  for (int e = 0; e < 8; ++e) {
    float pv = DPPF(v[e], 0x4E);
    float cs = tb[2 * e], sn = tb[2 * e + 1];
    v[e] = is_x1 ? (v[e] * cs - pv * sn) : (pv * sn + v[e] * cs);
  }
}

DI void r1_phase(const Params& p, int l, char* smem) {
  const int tid = tid_opaque(), lane = tid & 63, w = tid >> 6;
  u16* sT = (u16*)smem;
  const float* PROJ = (const float*)(p.ws + OFF_PROJ);
  const float* r16 = (const float*)(p.ws + OFF_R16);
  const float* r8 = (const float*)(p.ws + OFF_R8);
  u16* QA = (u16*)(p.ws + OFF_QA); u16* CQ = (u16*)(p.ws + OFF_CQ); u16* UC = (u16*)(p.ws + OFF_UC); u16* VGT = (u16*)(p.ws + OFF_VGT);
  u16* KA = (u16*)(p.ws + OFF_KA); u16* VAT = (u16*)(p.ws + OFF_VAT); u16* CKV = (u16*)(p.ws + OFF_CKV); u16* KM = (u16*)(p.ws + OFF_KM);
  const float* aqn = p.aqn + l * 64; const float* akn = p.akn + l * 64; const float* mqn = p.mqn + l * 256; const float* mkvn = p.mkvn + l * 128;
  constexpr int NTB = T / 32;
  for (int task0 = blockIdx.x; task0 < NTB + 64; task0 += gridDim.x) {
    const int task = (task0 < 64) ? (NTB + task0) : (task0 - 64);
    __syncthreads();
    if (task < NTB) {
      const int t0 = task * 32;
      for (int q = 0; q < 8; ++q) {
        const int tl = w * 8 + q, t = t0 + tl;
        const float* pr = PROJ + (size_t)t * PLD;
        const bool lat = t >= TC;
        const int s = lat ? ((t - TC) & 2047) : (t & 255);
        const int bctx = t >> 8;
        const int rowp = s >> 6, colp = s & 63;
        const int kr = tok_keyrow(t);
        const int c = lane & 7;
        {
          f32x4 a = *(const f32x4*)(pr + lane * 8), b = *(const f32x4*)(pr + lane * 8 + 4);
          float v[8] = {a[0], a[1], a[2], a[3], b[0], b[1], b[2], b[3]};
          float ss = 0.f;
#pragma unroll
          for (int e = 0; e < 8; ++e) ss += v[e] * v[e];
          ss += DPPF(ss, 0xB1); ss += DPPF(ss, 0x4E); ss += DPPF(ss, 0x141);
          float rinv = rsqrtf(ss * (1.f / 64.f) + EPS);
#pragma unroll
          for (int e = 0; e < 8; ++e) v[e] = v[e] * rinv * aqn[c * 8 + e];
          if (lat) rope16_apply(v, c, rowp, colp, r16);
          const float sc = 0.125f * LOG2E;
          u32x4 o = {pk2(v[0] * sc, v[1] * sc), pk2(v[2] * sc, v[3] * sc), pk2(v[4] * sc, v[5] * sc), pk2(v[6] * sc, v[7] * sc)};
          *(u32x4*)(QA + (size_t)t * 512 + lane * 8) = o;
        }
        {
          const int ln = lane & 31;
          f32x4 a = *(const f32x4*)(pr + 512 + ln * 8), b = *(const f32x4*)(pr + 512 + ln * 8 + 4);
          float v[8] = {a[0], a[1], a[2], a[3], b[0], b[1], b[2], b[3]};
          float ss = 0.f;
#pragma unroll
          for (int e = 0; e < 8; ++e) ss += v[e] * v[e];
          ss += DPPF(ss, 0xB1); ss += DPPF(ss, 0x4E); ss += DPPF(ss, 0x141);
          float rinv = rsqrtf(ss * (1.f / 64.f) + EPS);
          float kv[8];
#pragma unroll
          for (int e = 0; e < 8; ++e) kv[e] = v[e] * rinv * akn[c * 8 + e];
          if (!lat && lane < 16) {
            float* o = p.out + OUT_K + ((size_t)((bctx * 2 + l) * 256 + s)) * 128 + lane * 8;
            f32x4 o0 = {kv[0], kv[1], kv[2], kv[3]}, o1 = {kv[4], kv[5], kv[6], kv[7]};
            *(f32x4*)o = o0; *(f32x4*)(o + 4) = o1;
          }
          if (lat) rope16_apply(kv, c, rowp, colp, r16);
          if (lane < 16) {
            u32x4 o = {pk2(kv[0], kv[1]), pk2(kv[2], kv[3]), pk2(kv[4], kv[5]), pk2(kv[6], kv[7])};
            *(u32x4*)(KA + (size_t)kr * 128 + lane * 8) = o;
          } else if (lane < 32) {
            const int ch = (lane - 16) * 8;
            if (!lat) {
              float* o = p.out + OUT_V + ((size_t)((bctx * 2 + l) * 256 + s)) * 128 + ch;
              *(f32x4*)o = a; *(f32x4*)(o + 4) = b;
            }
#pragma unroll
            for (int e = 0; e < 8; ++e) sT[(ch + e) * 40 + tl] = (u16)(pk2(v[e], 0.f) & 0xffffu);
          }
        }
        {
          f32x4 a = *(const f32x4*)(pr + 768 + lane * 4);
          float ss = a[0] * a[0] + a[1] * a[1] + a[2] * a[2] + a[3] * a[3];
          ss = wave_sum(ss);
          float rinv = rsqrtf(ss * (1.f / 256.f) + EPS);
          f32x4 gq = *(const f32x4*)(mqn + lane * 4);
          u32x2 o = {pk2(a[0] * rinv * gq[0], a[1] * rinv * gq[1]), pk2(a[2] * rinv * gq[2], a[3] * rinv * gq[3])};
          *(u32x2*)(CQ + (size_t)t * 256 + lane * 4) = o;
        }
        {
          f32x2_t a = *(const f32x2_t*)(pr + 1024 + lane * 2);
          float ss = wave_sum(a[0] * a[0] + a[1] * a[1]);
          float rinv = rsqrtf(ss * (1.f / 128.f) + EPS);
          float c0 = a[0] * rinv * mkvn[lane * 2], c1 = a[1] * rinv * mkvn[lane * 2 + 1];
          if (!lat) { f32x2_t o = {c0, c1}; *(f32x2_t*)(p.out + OUT_CKV + ((size_t)((bctx * 2 + l) * 256 + s)) * 128 + lane * 2) = o; }
          *(unsigned*)(CKV + (size_t)kr * 128 + lane * 2) = pk2(c0, c1);
        }
        {
          const int ln = lane & 31;
          float v = pr[1152 + ln];
          if (!lat && lane < 32) p.out[OUT_KR + ((size_t)((bctx * 2 + l) * 256 + s)) * 32 + ln] = v;
          if (lat) {
            float pv = DPPF(v, 0x128);
            const int pos = (ln >> 4) ? colp : rowp;
            const float* tb = r8 + (size_t)(pos * 8 + (ln & 7)) * 2;
            float cs = tb[0], sn = tb[1];
            v = (ln & 8) ? (pv * sn + v * cs) : (v * cs - pv * sn);
          }
          if (lane < 32) {
            u16 hv = (u16)(pk2(v, 0.f) & 0xffffu);
#pragma unroll
            for (int h = 0; h < 4; ++h) KM[(size_t)kr * 384 + h * 96 + 64 + ln] = hv;
          }
        }
        {
          f32x4 a = *(const f32x4*)(pr + 1184 + lane * 4);
          u32x2 o = {pk2(a[0], a[1]), pk2(a[2], a[3])};
          *(u32x2*)(UC + (size_t)t * 256 + lane * 4) = o;
        }
        {
          f32x4 a = *(const f32x4*)(pr + 1440 + lane * 4);
          float sm = a[0] + a[1] + a[2] + a[3];
          sm += DPPF(sm, 0xB1); sm += DPPF(sm, 0x4E); sm += DPPF(sm, 0x141); sm += DPPF(sm, 0x140);
          float mu = sm * (1.f / 64.f);
          float d0 = a[0] - mu, d1 = a[1] - mu, d2 = a[2] - mu, d3 = a[3] - mu;
          float q2 = d0 * d0 + d1 * d1 + d2 * d2 + d3 * d3;
          q2 += DPPF(q2, 0xB1); q2 += DPPF(q2, 0x4E); q2 += DPPF(q2, 0x141); q2 += DPPF(q2, 0x140);
          float rstd = rsqrtf(q2 * (1.f / 64.f) + EPS);
          unsigned u0 = pk2(d0 * rstd, d1 * rstd), u1 = pk2(d2 * rstd, d3 * rstd);
          const int ch = 128 + lane * 4;
          sT[(ch + 0) * 40 + tl] = (u16)(u0 & 0xffffu); sT[(ch + 1) * 40 + tl] = (u16)(u0 >> 16);
          sT[(ch + 2) * 40 + tl] = (u16)(u1 & 0xffffu); sT[(ch + 3) * 40 + tl] = (u16)(u1 >> 16);
        }
      }
      __syncthreads();
      const int kr0 = tok_keyrow(t0);
      const int chunk = t0 >> 7, q0 = t0 & 127;
#pragma unroll
      for (int it = 0; it < 6; ++it) {
        int id = tid + 256 * it, row = id >> 2, cc = id & 3;
        u32x4 v = *(const u32x4*)(sT + row * 40 + cc * 8);
        if (row < 128) *(u32x4*)(VAT + vt_index(kr0, row, 128) + cc * 8) = v;
        else { int gd = row - 128; *(u32x4*)(VGT + ((size_t)(chunk * 256 + gd)) * 128 + q0 + cc * 8) = v; }
      }
    } else {
      const int j = task - NTB, bl = j >> 3, p0 = (j & 7) * 32;
      for (int q = 0; q < 8; ++q) {
        const int tl = w * 8 + q, pp = p0 + tl;
        const size_t crow = (size_t)((bl * 2 + l) * 256 + pp);
        const int kr = TC + bl * 2304 + pp;
        f32x2_t k2 = *(const f32x2_t*)(p.cache_k + crow * 128 + lane * 2);
        *(unsigned*)(KA + (size_t)kr * 128 + lane * 2) = pk2(k2[0], k2[1]);
        f32x2_t v2 = *(const f32x2_t*)(p.cache_v + crow * 128 + lane * 2);
        unsigned uv = pk2(v2[0], v2[1]);
        sT[(lane * 2) * 40 + tl] = (u16)(uv & 0xffffu); sT[(lane * 2 + 1) * 40 + tl] = (u16)(uv >> 16);
        f32x2_t c2 = *(const f32x2_t*)(p.cache_ckv + crow * 128 + lane * 2);
        *(unsigned*)(CKV + (size_t)kr * 128 + lane * 2) = pk2(c2[0], c2[1]);
        if (lane < 32) {
          float v = p.cache_kr[crow * 32 + lane];
          u16 hv = (u16)(pk2(v, 0.f) & 0xffffu);
#pragma unroll
          for (int h = 0; h < 4; ++h) KM[(size_t)kr * 384 + h * 96 + 64 + lane] = hv;
        }
      }
      __syncthreads();
      const int kr0 = TC + bl * 2304 + p0;
#pragma unroll
      for (int it = 0; it < 2; ++it) {
        int id = tid + 256 * it, row = id >> 2, cc = id & 3;
        u32x4 v = *(const u32x4*)(sT + row * 40 + cc * 8);
        *(u32x4*)(VAT + vt_index(kr0, row, 128) + cc * 8) = v;
      }
    }
  }
}

DI void mid_phase(const Params& p, int l, char* smem) {
  const int tid = tid_opaque(), lane = tid & 63, w = tid >> 6, wm = w >> 1, wn = w & 1, r = lane & 31, g = lane >> 5;
  constexpr int N_G2 = 192 * 3, N_G3 = 208 * 4, N_C1 = 192 * 4;
  for (int task = blockIdx.x; task < N_G2 + N_G3 + N_C1; task += gridDim.x) {
    if (task < N_G2) {
      const int tt = task / 3, nt = task % 3;
      const u16* W = (const u16*)(p.ws + OFF_WUQ) + (size_t)l * 384 * 256;
      const u16* CQ = (const u16*)(p.ws + OFF_CQ);
      u16* QM = (u16*)(p.ws + OFF_QM);
      const float* r8 = (const float*)(p.ws + OFF_R8);
      f32x16 acc[2][2];
      gemm_mainloop(W + (size_t)nt * 128 * 256, 256, CQ + (size_t)tt * 128 * 256, 256, 256, smem, acc);
      const float sc = LOG2E * 0.10206207261596577f;
#pragma unroll
      for (int mi = 0; mi < 2; ++mi) {
        const int nb = nt * 128 + 64 * wm + 32 * mi;
        const bool is_rope = (nb % 96) == 64;
#pragma unroll
        for (int ni = 0; ni < 2; ++ni) {
          const int t = tt * 128 + 64 * wn + 32 * ni + r;
          float v[16];
#pragma unroll
          for (int i = 0; i < 16; ++i) v[i] = acc[mi][ni][i];
          if (is_rope && t >= TC) {
            const int s = (t - TC) & 2047, rowp = s >> 6, colp = s & 63;
#pragma unroll
            for (int j = 0; j < 4; ++j) {
              const float* tb = r8 + (size_t)(rowp * 8 + 4 * g + j) * 2;
              float cs = tb[0], sn = tb[1];
              float x1 = v[j], x2 = v[4 + j];
              v[j] = x1 * cs - x2 * sn; v[4 + j] = x1 * sn + x2 * cs;
              const float* tc = r8 + (size_t)(colp * 8 + 4 * g + j) * 2;
              cs = tc[0]; sn = tc[1];
              x1 = v[8 + j]; x2 = v[12 + j];
              v[8 + j] = x1 * cs - x2 * sn; v[12 + j] = x1 * sn + x2 * cs;
            }
          }
#pragma unroll
          for (int i = 0; i < 4; ++i) {
            u32x2 o = {pk2(v[4 * i] * sc, v[4 * i + 1] * sc), pk2(v[4 * i + 2] * sc, v[4 * i + 3] * sc)};
            *(u32x2*)(QM + (size_t)t * 384 + nb + 8 * i + 4 * g) = o;
          }
        }
      }
    } else if (task < N_G2 + N_G3) {
      const int j = task - N_G2, tt = j >> 2, h = j & 3;
      const u16* W = (const u16*)(p.ws + OFF_WUKV) + (size_t)l * 512 * 128;
      const u16* CKV = (const u16*)(p.ws + OFF_CKV);
      u16* KM = (u16*)(p.ws + OFF_KM); u16* VMT = (u16*)(p.ws + OFF_VMT);
      f32x16 acc[2][2];
      gemm_mainloop(W + (size_t)h * 128 * 128, 128, CKV + (size_t)tt * 128 * 128, 128, 128, smem, acc);
#pragma unroll
      for (int mi = 0; mi < 2; ++mi)
#pragma unroll
        for (int ni = 0; ni < 2; ++ni) {
          const int kr = tt * 128 + 64 * wn + 32 * ni + r;
          if (wm == 0) {
#pragma unroll
            for (int i = 0; i < 4; ++i) {
              u32x2 o = {pk2(acc[mi][ni][4 * i], acc[mi][ni][4 * i + 1]), pk2(acc[mi][ni][4 * i + 2], acc[mi][ni][4 * i + 3])};
              *(u32x2*)(KM + (size_t)kr * 384 + h * 96 + 32 * mi + 8 * i + 4 * g) = o;
            }
          } else {
            size_t vbase; int lseq;
            if (kr < TC) { vbase = (size_t)(kr >> 8) * 256 * 256 + (kr & 255); lseq = 256; }
            else { const int u = kr - TC, bl = u / 2304, pos = u - bl * 2304; vbase = (size_t)32 * 256 * 256 + (size_t)bl * 256 * 2304 + pos; lseq = 2304; }
            u16* vp = VMT + vbase + (size_t)(h * 64 + 32 * mi + 4 * g) * lseq;
#pragma unroll
            for (int i = 0; i < 16; ++i)
              vp[(size_t)(8 * (i >> 2) + (i & 3)) * lseq] = (u16)(pk2(acc[mi][ni][i], 0.f) & 0xffffu);
          }
        }
    } else {
      const int j = task - N_G2 - N_G3, chunk = j >> 2, gg = j & 3;
      const u16* WS = (const u16*)(p.ws + OFF_GWS) + (size_t)(l * 4 + gg) * 128 * 128;
      const u16* VGT = (const u16*)(p.ws + OFF_VGT) + (size_t)(chunk * 4 + gg) * 64 * 128;
      const u16* UC = (const u16*)(p.ws + OFF_UC);
      u16* MIXIN = (u16*)(p.ws + OFF_MIXIN);
      f32x16 acc[2];
#pragma unroll
      for (int i = 0; i < 16; ++i) { acc[0][i] = 0.f; acc[1][i] = 0.f; }
      const int pp = 32 * w + r;
#pragma unroll
      for (int ks = 0; ks < 8; ++ks) {
        bf16x8 b = *(const bf16x8*)(WS + (size_t)pp * 128 + ks * 16 + 8 * g);
#pragma unroll
        for (int mt = 0; mt < 2; ++mt) {
          bf16x8 a = *(const bf16x8*)(VGT + (size_t)(32 * mt + r) * 128 + ks * 16 + 8 * g);
          acc[mt] = MFMA32(a, b, acc[mt]);
        }
      }
      const float bs = p.gb[(size_t)(l * 4 + gg) * 128 + pp];
      const int t = chunk * 128 + pp;
#pragma unroll
      for (int mt = 0; mt < 2; ++mt)
#pragma unroll
        for (int i = 0; i < 4; ++i) {
          const int d = 32 * mt + 8 * i + 4 * g;
          u32x2 u = *(const u32x2*)(UC + (size_t)t * 256 + gg * 64 + d);
          float o0 = bflo(u[0]) * (acc[mt][4 * i] + bs), o1 = bfhi(u[0]) * (acc[mt][4 * i + 1] + bs);
          float o2 = bflo(u[1]) * (acc[mt][4 * i + 2] + bs), o3 = bfhi(u[1]) * (acc[mt][4 * i + 3] + bs);
          u32x2 o = {pk2(o0, o1), pk2(o2, o3)};
          *(u32x2*)(MIXIN + (size_t)t * HP + 768 + gg * 64 + d) = o;
        }
    }
  }
}

template <int DK>
DI void attn_item(const u16* __restrict__ Q, int ldq, const u16* __restrict__ Kp, int ldk, const u16* __restrict__ VT, int L,
                  u16* __restrict__ O, char* smem) {
  constexpr int KS = DK / 16, KROW = (DK + 8) * 2, KCH = DK / 8, NKC = 64 * KCH / 256;
  const int tid = tid_opaque(), lane = tid & 63, w = tid >> 6, r = lane & 31, g = lane >> 5;
  char* Ks = smem; char* Vs = smem + 64 * KROW;
  bf16x8 qf[KS];
  {
    const u16* qrow = Q + (size_t)(32 * w + r) * ldq + 8 * g;
#pragma unroll
    for (int ks = 0; ks < KS; ++ks) qf[ks] = *(const bf16x8*)(qrow + 16 * ks);
  }
  f32x16 o[2];
#pragma unroll
  for (int i = 0; i < 16; ++i) { o[0][i] = 0.f; o[1][i] = 0.f; }
  float m = -1e30f, lsum = 0.f;
  u32x4 kreg[NKC], vreg[2];
#pragma unroll
  for (int i = 0; i < NKC; ++i) { int id = tid + 256 * i, row = id / KCH, c = id % KCH; kreg[i] = *(const u32x4*)(Kp + (size_t)row * ldk + c * 8); }
#pragma unroll
  for (int i = 0; i < 2; ++i) { int id = tid + 256 * i, row = id >> 3, c = id & 7; vreg[i] = *(const u32x4*)(VT + (size_t)row * L + c * 8); }
  for (int key0 = 0; key0 < L; key0 += 64) {
    __syncthreads();
#pragma unroll
    for (int i = 0; i < NKC; ++i) { int id = tid + 256 * i, row = id / KCH, c = id % KCH; *(u32x4*)(Ks + row * KROW + c * 16) = kreg[i]; }
#pragma unroll
    for (int i = 0; i < 2; ++i) { int id = tid + 256 * i, row = id >> 3, c = id & 7; *(u32x4*)(Vs + row * 144 + c * 16) = vreg[i]; }
    __syncthreads();
    if (key0 + 64 < L) {
      const int kn = key0 + 64;
#pragma unroll
      for (int i = 0; i < NKC; ++i) { int id = tid + 256 * i, row = id / KCH, c = id % KCH; kreg[i] = *(const u32x4*)(Kp + (size_t)(kn + row) * ldk + c * 8); }
#pragma unroll
      for (int i = 0; i < 2; ++i) { int id = tid + 256 * i, row = id >> 3, c = id & 7; vreg[i] = *(const u32x4*)(VT + (size_t)row * L + kn + c * 8); }
    }
    __builtin_amdgcn_s_setprio(2);
    f32x16 s[2];
#pragma unroll
    for (int i = 0; i < 16; ++i) { s[0][i] = 0.f; s[1][i] = 0.f; }
#pragma unroll
    for (int ks = 0; ks < KS; ++ks)
#pragma unroll
      for (int mt = 0; mt < 2; ++mt) {
        bf16x8 a = *(const bf16x8*)(Ks + (32 * mt + r) * KROW + (16 * ks + 8 * g) * 2);
        s[mt] = MFMA32(a, qf[ks], s[mt]);
      }
    float mx = s[0][0];
#pragma unroll
    for (int i = 0; i < 16; ++i) { mx = fmaxf(mx, s[0][i]); mx = fmaxf(mx, s[1][i]); }
    { const auto sw = __builtin_amdgcn_permlane32_swap(__float_as_uint(mx), __float_as_uint(mx), false, false); mx = fmaxf(__uint_as_float(sw[0]), __uint_as_float(sw[1])); }
    const float mnew = fmaxf(m, mx);
    const float alpha = __builtin_amdgcn_exp2f(m - mnew);
    m = mnew;
    float ps = 0.f;
#pragma unroll
    for (int mt = 0; mt < 2; ++mt)
#pragma unroll
      for (int i = 0; i < 16; ++i) { float e = __builtin_amdgcn_exp2f(s[mt][i] - mnew); s[mt][i] = e; ps += e; }
    lsum = lsum * alpha + ps;
#pragma unroll
    for (int i = 0; i < 16; ++i) { o[0][i] *= alpha; o[1][i] *= alpha; }
#pragma unroll
    for (int mt = 0; mt < 2; ++mt)
#pragma unroll
      for (int ip = 0; ip < 2; ++ip) {
        u32x4 pb = {pk2(s[mt][8 * ip], s[mt][8 * ip + 1]), pk2(s[mt][8 * ip + 2], s[mt][8 * ip + 3]),
                    pk2(s[mt][8 * ip + 4], s[mt][8 * ip + 5]), pk2(s[mt][8 * ip + 6], s[mt][8 * ip + 7])};
        bf16x8 pbv = __builtin_bit_cast(bf16x8, pb);
#pragma unroll
        for (int dt = 0; dt < 2; ++dt) {
          const char* vrow = Vs + (32 * dt + r) * 144 + (32 * mt + 16 * ip + 4 * g) * 2;
          u32x2 lo = *(const u32x2*)(vrow), hi = *(const u32x2*)(vrow + 16);
          u32x4 av = {lo[0], lo[1], hi[0], hi[1]};
          o[dt] = MFMA32(__builtin_bit_cast(bf16x8, av), pbv, o[dt]);
        }
      }
    __builtin_amdgcn_s_setprio(0);
  }
  { const auto sw = __builtin_amdgcn_permlane32_swap(__float_as_uint(lsum), __float_as_uint(lsum), false, false); lsum = __uint_as_float(sw[0]) + __uint_as_float(sw[1]); }
  const float inv = 1.f / lsum;
  u16* orow = O + (size_t)(32 * w + r) * HP;
#pragma unroll
  for (int dt = 0; dt < 2; ++dt)
#pragma unroll
    for (int i = 0; i < 4; ++i) {
      u32x2 ov = {pk2(o[dt][4 * i] * inv, o[dt][4 * i + 1] * inv), pk2(o[dt][4 * i + 2] * inv, o[dt][4 * i + 3] * inv)};
      *(u32x2*)(orow + 32 * dt + 8 * i + 4 * g) = ov;
    }
}

DI void attn_phase(const Params& p, char* smem) {
  const u16* QA = (const u16*)(p.ws + OFF_QA); const u16* QM = (const u16*)(p.ws + OFF_QM);
  const u16* KA = (const u16*)(p.ws + OFF_KA); const u16* KM = (const u16*)(p.ws + OFF_KM);
  const u16* VAT = (const u16*)(p.ws + OFF_VAT); const u16* VMT = (const u16*)(p.ws + OFF_VMT);
  u16* MIXIN = (u16*)(p.ws + OFF_MIXIN);
  const int xq = blockIdx.x & 7, qq = blockIdx.x >> 3, nbx = (int)((gridDim.x - xq + 7) >> 3);
  for (int i = qq; i < 288; i += nbx) {
    if (i < 64) {
      const int bl = xq, h = i >> 4, qb = i & 15;
      const int t0 = TC + bl * 2048 + qb * 128, kr0 = TC + bl * 2304;
      attn_item<96>(QM + (size_t)t0 * 384 + h * 96, 384, KM + (size_t)kr0 * 384 + h * 96, 384,
                    VMT + (size_t)32 * 256 * 256 + (size_t)(bl * 256 + h * 64) * 2304, 2304, MIXIN + (size_t)t0 * HP + 512 + h * 64, smem);
    } else if (i < 192) {
      const int j = i - 64, bl = xq, hq = j >> 4, qb = j & 15, kvh = hq >> 2;
      const int t0 = TC + bl * 2048 + qb * 128, kr0 = TC + bl * 2304;
      attn_item<64>(QA + (size_t)t0 * 512 + hq * 64, 512, KA + (size_t)kr0 * 128 + kvh * 64, 128,
                    VAT + (size_t)32 * 128 * 256 + (size_t)(bl * 128 + kvh * 64) * 2304, 2304, MIXIN + (size_t)t0 * HP + hq * 64, smem);
    } else {
      const int j = i - 192, b = xq * 4 + j / 24, rem = j % 24;
      const int kr0 = b * 256;
      if (rem < 8) {
        const int h = rem >> 1, qb = rem & 1, t0 = b * 256 + qb * 128;
        attn_item<96>(QM + (size_t)t0 * 384 + h * 96, 384, KM + (size_t)kr0 * 384 + h * 96, 384,
                      VMT + (size_t)(b * 256 + h * 64) * 256, 256, MIXIN + (size_t)t0 * HP + 512 + h * 64, smem);
      } else {
        const int rr = rem - 8, hq = rr >> 1, qb = rr & 1, kvh = hq >> 2, t0 = b * 256 + qb * 128;
        attn_item<64>(QA + (size_t)t0 * 512 + hq * 64, 512, KA + (size_t)kr0 * 128 + kvh * 64, 128,
                      VAT + (size_t)(b * 128 + kvh * 64) * 256, 256, MIXIN + (size_t)t0 * HP + hq * 64, smem);
      }
    }
  }
}

DI void g4_phase(const Params& p, int l, char* smem) {
  const u16* W = (const u16*)(p.ws + OFF_WO) + (size_t)l * 1024 * WP;
  const u16* X = (const u16*)(p.ws + OFF_MIXIN);
  float* C = (float*)(p.ws + OFF_MIXOUT);
  const int xq = blockIdx.x & 7, qq = blockIdx.x >> 3, nbx = (int)((gridDim.x - xq + 7) >> 3);
  for (int i = qq; i < 24 * 8; i += nbx) {
    const int tt = (i >> 3) * 8 + xq, nt = i & 7;
    f32x16 acc[2][2];
    gemm_mainloop(W + (size_t)nt * 128 * WP, WP, X + (size_t)tt * 128 * HP, HP, 1024, smem, acc);
    epi_store_f32(acc, C, MP, nt * 128, tt * 128);
  }
}

DI void r2_phase(const Params& p, int l) {
  const int lane = tid_opaque() & 63, w = tid_opaque() >> 6;
  float* MIX = (float*)(p.ws + OFF_MIXOUT);
  u16* H2 = (u16*)(p.ws + OFF_H2);
  const float* lg = p.ln1g + l * 1024; const float* lb = p.ln1b + l * 1024;
  for (int t = blockIdx.x * 4 + w; t < T; t += gridDim.x * 4) {
    const float* xr = (l == 0) ? xin_row(p, t) : (p.out + (size_t)t * 1024);
    const float* m = (const float*)(p.ws + OFF_MOD) + (size_t)(l * 9 + tok_modrow(t)) * 6144;
    float y[16];
#pragma unroll
    for (int i = 0; i < 4; ++i) {
      int c = 4 * (lane + 64 * i);
      f32x4 xv = *(const f32x4*)(xr + c), mv = *(const f32x4*)(MIX + (size_t)t * MP + c), g1 = *(const f32x4*)(m + 2048 + c);
#pragma unroll
      for (int e = 0; e < 4; ++e) y[4 * i + e] = ALPHA * xv[e] + g1[e] * mv[e];
    }
    float mu, rstd; ln_stats16(y, mu, rstd);
#pragma unroll
    for (int i = 0; i < 4; ++i) {
      int c = 4 * (lane + 64 * i);
      f32x4 gv = *(const f32x4*)(lg + c), bv = *(const f32x4*)(lb + c);
      f32x4 o;
#pragma unroll
      for (int e = 0; e < 4; ++e) { y[4 * i + e] = (y[4 * i + e] - mu) * rstd * gv[e] + bv[e]; o[e] = y[4 * i + e]; }
      *(f32x4*)(MIX + (size_t)t * MP + c) = o;
    }
    ln_stats16(y, mu, rstd);
#pragma unroll
    for (int i = 0; i < 4; ++i) {
      int c = 4 * (lane + 64 * i);
      f32x4 sh = *(const f32x4*)(m + 3072 + c), sc = *(const f32x4*)(m + 4096 + c);
      float h[4];
#pragma unroll
      for (int e = 0; e < 4; ++e) h[e] = (y[4 * i + e] - mu) * rstd * (1.f + sc[e]) + sh[e];
      u32x2 o = {pk2(h[0], h[1]), pk2(h[2], h[3])};
      *(u32x2*)(H2 + (size_t)t * HP + c) = o;
    }
  }
}

DI void ce_desc(unsigned& a, unsigned& b) { unsigned mx = a > b ? a : b, mn = a > b ? b : a; a = mx; b = mn; }
DI void sort16_desc(unsigned (&a)[16]) {
#pragma unroll
  for (int k = 2; k <= 16; k <<= 1) {
#pragma unroll
    for (int j = k >> 1; j > 0; j >>= 1) {
#pragma unroll
      for (int i = 0; i < 16; ++i) {
        const int l2 = i ^ j;
        if (l2 > i) { if ((i & k) == 0) ce_desc(a[i], a[l2]); else ce_desc(a[l2], a[i]); }
      }
    }
  }
}
DI void merge16_desc(unsigned (&a)[16]) {
#pragma unroll
  for (int j = 8; j > 0; j >>= 1) {
#pragma unroll
    for (int i = 0; i < 16; ++i) { const int l2 = i ^ j; if (l2 > i) ce_desc(a[i], a[l2]); }
  }
}
DI void top16_merge(unsigned (&a)[16], const unsigned (&b)[16]) {
#pragma unroll
  for (int i = 0; i < 16; ++i) a[i] = a[i] > b[15 - i] ? a[i] : b[15 - i];
  merge16_desc(a);
}
DI unsigned score_key(float f, int idx) {
  unsigned u = __float_as_uint(f);
  u ^= (unsigned)((int)u >> 31) | 0x80000000u;
  return (u & ~127u) | (unsigned)(127 - idx);
}
DI float key_val(unsigned k) {
  unsigned u = k & ~127u;
  u = (u & 0x80000000u) ? (u ^ 0x80000000u) : ~u;
  return __uint_as_float(u);
}

DI void g5_phase(const Params& p, int l, char* smem) {
  const int tid = tid_opaque(), lane = tid & 63, w = tid >> 6, wm = w >> 1, wn = w & 1, r = lane & 31, g = lane >> 5;
  const u16* W = (const u16*)(p.ws + OFF_PWQ) + (size_t)l * 2048 * WP;
  const u16* X = (const u16*)(p.ws + OFF_H2);
  unsigned* TOPK = (unsigned*)(p.ws + OFF_TOPK);
  char* Qs = smem;
  const int xq = blockIdx.x & 7, qq = blockIdx.x >> 3, nbx = (int)((gridDim.x - xq + 7) >> 3);
  for (int i = qq; i < 24 * 16; i += nbx) {
    const int tt = (i >> 4) * 8 + xq, nt = i & 15;
    f32x16 acc[2][2];
    gemm_mainloop(W + (size_t)nt * 128 * WP, WP, X + (size_t)tt * 128 * HP, HP, 1024, smem, acc);
    __syncthreads();
#pragma unroll
    for (int mi = 0; mi < 2; ++mi)
#pragma unroll
      for (int ni = 0; ni < 2; ++ni)
#pragma unroll
        for (int i = 0; i < 4; ++i) {
          u32x2 o = {pk2(acc[mi][ni][4 * i], acc[mi][ni][4 * i + 1]), pk2(acc[mi][ni][4 * i + 2], acc[mi][ni][4 * i + 3])};
          *(u32x2*)(Qs + (64 * wn + 32 * ni + r) * 272 + (64 * wm + 32 * mi + 8 * i + 4 * g) * 2) = o;
        }
    __syncthreads();
    const int h = nt >> 1, half = nt & 1;
    const u16* PK = (const u16*)(p.ws + OFF_PK) + (size_t)(l * 2 + half) * 16384;
    unsigned z[16], y[16];
#pragma unroll
    for (int i = 0; i < 16; ++i) z[i] = 0u;
    bf16x8 qfr[8];
#pragma unroll
    for (int ks = 0; ks < 8; ++ks) qfr[ks] = *(const bf16x8*)(Qs + (32 * w + r) * 272 + (16 * ks + 8 * g) * 2);
#pragma unroll 1
    for (int mt = 0; mt < 4; ++mt) {
      f32x16 sc;
#pragma unroll
      for (int i = 0; i < 16; ++i) sc[i] = 0.f;
#pragma unroll
      for (int ks = 0; ks < 8; ++ks) {
        bf16x8 a = *(const bf16x8*)(PK + (size_t)(32 * mt + r) * 128 + 16 * ks + 8 * g);
        sc = MFMA32(a, qfr[ks], sc);
      }
#pragma unroll
      for (int i = 0; i < 16; ++i) y[i] = score_key(sc[i], 32 * mt + 8 * (i >> 2) + 4 * g + (i & 3));
      sort16_desc(y);
      top16_merge(z, y);
    }
#pragma unroll
    for (int i = 0; i < 16; ++i) { const auto sw = __builtin_amdgcn_permlane32_swap(z[i], z[i], false, false); y[15 - i] = g ? sw[0] : sw[1]; }
#pragma unroll
    for (int i = 0; i < 16; ++i) z[i] = z[i] > y[i] ? z[i] : y[i];
    merge16_desc(z);
    if (g == 0) {
      const int t = tt * 128 + 32 * w + r;
      unsigned* dst = TOPK + ((size_t)(t * 8 + h) * 2 + half) * 16;
#pragma unroll
      for (int i = 0; i < 4; ++i) { u32x4 o = {z[4 * i], z[4 * i + 1], z[4 * i + 2], z[4 * i + 3]}; *(u32x4*)(dst + 4 * i) = o; }
    }
  }
}

DI constexpr int sel_pi(int m) { return m < 16 ? 0 : m < 24 ? 1 : m < 29 ? 2 : m < 33 ? 3 : m < 36 ? 4 : m < 38 ? 5 : m < 40 ? 6 : m < 42 ? 7 : m < 50 ? m - 34 : 0; }
DI constexpr int sel_pj(int m) { return m < 16 ? m : m < 24 ? m - 16 : m < 29 ? m - 24 : m < 33 ? m - 29 : m < 36 ? m - 33 : m < 38 ? m - 36 : m < 40 ? m - 38 : m < 42 ? m - 40 : 0; }
DI unsigned sum_key(float f, int m) {
  unsigned u = __float_as_uint(f);
  u ^= (unsigned)((int)u >> 31) | 0x80000000u;
  return (u & ~63u) | (unsigned)(63 - m);
}
DI float sum_key_val(unsigned k) {
  unsigned u = k & ~63u;
  u = (u & 0x80000000u) ? (u ^ 0x80000000u) : ~u;
  return __uint_as_float(u);
}
DI void sel_phase(const Params& p, int l, char* smem) {
  const int tid = tid_opaque();
  unsigned char* s_tab = (unsigned char*)smem;
  unsigned char* s_ii = (unsigned char*)smem + 256 + tid * 32;
  __syncthreads();
  if (tid < 64) { s_tab[2 * tid] = (unsigned char)sel_pi(tid); s_tab[2 * tid + 1] = (unsigned char)sel_pj(tid); }
  __syncthreads();
  const unsigned* TOPK = (const unsigned*)(p.ws + OFF_TOPK);
  const float* SU = (const float*)(p.ws + OFF_SU) + l * 16384;
  const float* SV = (const float*)(p.ws + OFF_SV) + l * 16384;
  int* SIDX = (int*)(p.ws + OFF_SIDX); float* SW = (float*)(p.ws + OFF_SW); float* SSU = (float*)(p.ws + OFF_SSU);
  for (int item = blockIdx.x * 256 + tid; item < T * 8; item += gridDim.x * 256) {
    const unsigned* tk = TOPK + (size_t)item * 32;
    float v1[16], v2[16];
#pragma unroll
    for (int q = 0; q < 4; ++q) {
      const u32x4 a = *(const u32x4*)(tk + 4 * q), b = *(const u32x4*)(tk + 16 + 4 * q);
#pragma unroll
      for (int e = 0; e < 4; ++e) {
        v1[4 * q + e] = key_val(a[e]); s_ii[4 * q + e] = (unsigned char)(127u - (a[e] & 127u));
        v2[4 * q + e] = key_val(b[e]); s_ii[16 + 4 * q + e] = (unsigned char)(127u - (b[e] & 127u));
      }
    }
    unsigned z[16], y[16];
#pragma unroll
    for (int i = 0; i < 16; ++i) z[i] = sum_key(v1[sel_pi(i)] + v2[sel_pj(i)], i);
    sort16_desc(z);
#pragma unroll
    for (int gq = 1; gq < 4; ++gq) {
#pragma unroll
      for (int i = 0; i < 16; ++i) { const int m = 16 * gq + i; y[i] = (m < 50) ? sum_key(v1[sel_pi(m)] + v2[sel_pj(m)], m) : 0u; }
      sort16_desc(y);
      top16_merge(z, y);
    }
    const float mx = sum_key_val(z[0]);
    float ev[16], sum = 0.f;
#pragma unroll
    for (int r = 0; r < 16; ++r) { ev[r] = __expf(sum_key_val(z[r]) - mx); sum += ev[r]; }
    const float inv = 1.f / sum;
    int id[16];
#pragma unroll
    for (int r = 0; r < 16; ++r) {
      const int m = 63 - (int)(z[r] & 63u);
      const int ci = s_tab[2 * m], cj = s_tab[2 * m + 1];
      id[r] = (int)s_ii[ci] * 128 + (int)s_ii[16 + cj];
    }
#pragma unroll
    for (int q = 0; q < 4; ++q) {
      u32x4 oi; f32x4 ow, os;
#pragma unroll
      for (int e = 0; e < 4; ++e) { const int r = 4 * q + e; oi[e] = (unsigned)id[r]; ow[e] = ev[r] * inv * SV[id[r]]; os[e] = SU[id[r]]; }
      *(u32x4*)(SIDX + (size_t)item * 16 + 4 * q) = oi;
      *(f32x4*)(SW + (size_t)item * 16 + 4 * q) = ow;
      *(f32x4*)(SSU + (size_t)item * 16 + 4 * q) = os;
    }
  }
}

#ifndef VRING
#define VRING 16
#endif
#define MFMA8(a, b, c) __builtin_amdgcn_mfma_f32_16x16x32_fp8_fp8((a), (b), (c), 0, 0, 0)
DI long mk64(unsigned lo, unsigned hi) { return (long)(((unsigned long)hi << 32) | (unsigned long)lo); }
DI void e_phase(const Params& p, int l, char* smem) {
  const int tid = tid_opaque(), lane = tid & 63, w = tid >> 6;
  char* xh = smem + w * 2048;
  char* xl = xh + 1024;
  int* s_idx = (int*)(smem + 8192) + w * 128;
  float* s_w = (float*)(smem + 8192 + 2048) + w * 128;
  float* s_su = (float*)(smem + 8192 + 4096) + w * 128;
  const u16* H2 = (const u16*)(p.ws + OFF_H2);
  const int* SIDX = (const int*)(p.ws + OFF_SIDX); const float* SW = (const float*)(p.ws + OFF_SW); const float* SSU = (const float*)(p.ws + OFF_SSU);
  const unsigned char* PU = (const unsigned char*)(p.ws + OFF_PU) + (size_t)l * 16384 * 512;
  const unsigned char* PV = (const unsigned char*)(p.ws + OFF_PV) + (size_t)l * 16384 * 512;
  const float* SU = (const float*)(p.ws + OFF_SU) + l * 16384;
  const float* SV = (const float*)(p.ws + OFF_SV) + l * 16384;
  const float* X1 = (const float*)(p.ws + OFF_MIXOUT);
  u16* H = (u16*)(p.ws + OFF_H);
  const float* lg = p.ln2g + l * 1024; const float* lb = p.ln2b + l * 1024;
  int ci, cj;
  {
    const int c = lane;
    if (c < 16) { ci = 0; cj = c; } else if (c < 24) { ci = 1; cj = c - 16; } else if (c < 29) { ci = 2; cj = c - 24; }
    else if (c < 33) { ci = 3; cj = c - 29; } else if (c < 36) { ci = 4; cj = c - 33; } else if (c < 38) { ci = 5; cj = c - 36; }
    else if (c < 40) { ci = 6; cj = c - 38; } else if (c < 42) { ci = 7; cj = c - 40; } else if (c < 50) { ci = c - 34; cj = 0; }
    else { ci = 0; cj = 0; }
  }
  const bool cand_ok = lane < 50;
  const int r16 = lane & 15, kq = lane >> 4;
  for (int t = blockIdx.x * 4 + w; t < T; t += gridDim.x * 4) {
    const int l32 = lane & 31, half = lane >> 5;
    f32x2_t xv[16];
    {
      const u16* hp = H2 + (size_t)t * HP + 32 * l32;
#pragma unroll
      for (int q = 0; q < 4; ++q) {
        const u32x4 a = *(const u32x4*)(hp + 8 * q);
#pragma unroll
        for (int i = 0; i < 4; ++i) { xv[4 * q + i][0] = bflo(a[i]); xv[4 * q + i][1] = bfhi(a[i]); }
      }
    }
#pragma unroll
    for (int j = 0; j < 2; ++j) {
      const int e = lane + 64 * j;
      s_idx[e] = SIDX[(size_t)t * 128 + e]; s_w[e] = SW[(size_t)t * 128 + e]; s_su[e] = SSU[(size_t)t * 128 + e];
    }
    __builtin_amdgcn_fence(__ATOMIC_SEQ_CST, "wavefront");
    __builtin_amdgcn_wave_barrier();
    const unsigned rlo = 16u * (unsigned)l32;
    {
      const bool b4 = (lane & 16) != 0, b3 = (lane & 8) != 0, b2 = (lane & 4) != 0;
      const int eloc = 2 * ((b4 ? 4 : 0) + (b3 ? 2 : 0) + (b2 ? 1 : 0)) + half;
      u32x4 ur[8];
#pragma unroll
      for (int pq = 0; pq < 8; ++pq) ur[pq] = *(const u32x4*)(PU + ((unsigned)s_idx[2 * pq + half] * 512u + rlo));
#pragma unroll 1
      for (int g = 0; g < 8; ++g) {
        float part[8];
        const int gn = (g + 1) & 7;
#pragma unroll
        for (int pq = 0; pq < 8; ++pq) {
          const u32x4 v = ur[pq];
          if (g < 7) ur[pq] = *(const u32x4*)(PU + ((unsigned)s_idx[gn * 16 + 2 * pq + half] * 512u + rlo));
          f32x2_t accv = {0.f, 0.f};
#pragma unroll
          for (int q = 0; q < 4; ++q) {
            f32x2_t d0 = __builtin_amdgcn_cvt_scalef32_pk_f32_fp4(v[q], 1.0f, 0), d1 = __builtin_amdgcn_cvt_scalef32_pk_f32_fp4(v[q], 1.0f, 1);
            f32x2_t d2 = __builtin_amdgcn_cvt_scalef32_pk_f32_fp4(v[q], 1.0f, 2), d3 = __builtin_amdgcn_cvt_scalef32_pk_f32_fp4(v[q], 1.0f, 3);
            accv += xv[4 * q] * d0; accv += xv[4 * q + 1] * d1; accv += xv[4 * q + 2] * d2; accv += xv[4 * q + 3] * d3;
          }
          part[pq] = accv[0] + accv[1];
          asm volatile("" : "+v"(part[pq]));
        }
        float p4[4], p2[2];
#pragma unroll
        for (int i = 0; i < 4; ++i) {
          const auto sw = __builtin_amdgcn_permlane16_swap(__float_as_uint(part[i]), __float_as_uint(part[4 + i]), false, false);
          p4[i] = __uint_as_float(sw[0]) + __uint_as_float(sw[1]);
        }
#pragma unroll
        for (int i = 0; i < 2; ++i) { const float mine = b3 ? p4[2 + i] : p4[i], oth = b3 ? p4[i] : p4[2 + i]; p2[i] = mine + DPPF(oth, 0x140); }
        float a1 = (b2 ? p2[1] : p2[0]) + DPPF(b2 ? p2[0] : p2[1], 0x141);
        a1 += DPPF(a1, 0x4E); a1 += DPPF(a1, 0xB1);
        const int e = g * 16 + eloc;
        const float wvv = s_w[e] * gelu_tanh(s_su[e] * a1);
        __builtin_amdgcn_fence(__ATOMIC_SEQ_CST, "wavefront");
        __builtin_amdgcn_wave_barrier();
        if ((lane & 3) == 0) s_w[e] = wvv;
      }
    }
    __builtin_amdgcn_fence(__ATOMIC_SEQ_CST, "wavefront");
    __builtin_amdgcn_wave_barrier();
    float ff[16];
    {
      f32x2_t fv[16];
#pragma unroll
      for (int i = 0; i < 16; ++i) { fv[i][0] = 0.f; fv[i][1] = 0.f; }
      u32x4 vr[8];
#pragma unroll
      for (int j = 0; j < 8; ++j) vr[j] = *(const u32x4*)(PV + ((unsigned)s_idx[2 * j + half] * 512u + rlo));
#pragma unroll 1
      for (int p0 = 0; p0 < 64; p0 += 8) {
        const int pn = (p0 + 8) & 63;
#pragma unroll
        for (int j = 0; j < 8; ++j) {
          const u32x4 v = vr[j];
          vr[j] = *(const u32x4*)(PV + ((unsigned)s_idx[2 * (pn + j) + half] * 512u + rlo));
          const float we = s_w[2 * (p0 + j) + half];
          const f32x2_t we2 = {we, we};
#pragma unroll
          for (int q = 0; q < 4; ++q) {
            f32x2_t d0 = __builtin_amdgcn_cvt_scalef32_pk_f32_fp4(v[q], 1.0f, 0), d1 = __builtin_amdgcn_cvt_scalef32_pk_f32_fp4(v[q], 1.0f, 1);
            f32x2_t d2 = __builtin_amdgcn_cvt_scalef32_pk_f32_fp4(v[q], 1.0f, 2), d3 = __builtin_amdgcn_cvt_scalef32_pk_f32_fp4(v[q], 1.0f, 3);
            fv[4 * q] += we2 * d0; fv[4 * q + 1] += we2 * d1; fv[4 * q + 2] += we2 * d2; fv[4 * q + 3] += we2 * d3;
          }
          asm volatile("" : "+v"(fv[0]), "+v"(fv[1]), "+v"(fv[2]), "+v"(fv[3]), "+v"(fv[4]), "+v"(fv[5]), "+v"(fv[6]), "+v"(fv[7]),
                            "+v"(fv[8]), "+v"(fv[9]), "+v"(fv[10]), "+v"(fv[11]), "+v"(fv[12]), "+v"(fv[13]), "+v"(fv[14]), "+v"(fv[15]));
        }
      }
#pragma unroll
      for (int i = 0; i < 8; ++i) {
        const auto s0 = __builtin_amdgcn_permlane32_swap(__float_as_uint(fv[i][0]), __float_as_uint(fv[8 + i][0]), false, false);
        const auto s1 = __builtin_amdgcn_permlane32_swap(__float_as_uint(fv[i][1]), __float_as_uint(fv[8 + i][1]), false, false);
        ff[2 * i] = __uint_as_float(s0[0]) + __uint_as_float(s0[1]);
        ff[2 * i + 1] = __uint_as_float(s1[0]) + __uint_as_float(s1[1]);
      }
    }
    const int cb = 32 * l32 + 16 * half;
    __builtin_amdgcn_fence(__ATOMIC_SEQ_CST, "wavefront");
    __builtin_amdgcn_wave_barrier();
    const float* m = (const float*)(p.ws + OFF_MOD) + (size_t)(l * 9 + tok_modrow(t)) * 6144;
    float y[16];
#pragma unroll
    for (int q = 0; q < 4; ++q) {
      const int c = cb + 4 * q;
      f32x4 xv = *(const f32x4*)(X1 + (size_t)t * MP + c), g2 = *(const f32x4*)(m + 5120 + c);
#pragma unroll
      for (int e = 0; e < 4; ++e) y[4 * q + e] = ALPHA * xv[e] + g2[e] * ff[4 * q + e];
    }
    float mu, rstd; ln_stats16(y, mu, rstd);
#pragma unroll
    for (int q = 0; q < 4; ++q) {
      const int c = cb + 4 * q;
      f32x4 gv = *(const f32x4*)(lg + c), bv = *(const f32x4*)(lb + c), o;
#pragma unroll
      for (int e = 0; e < 4; ++e) { float v = (y[4 * q + e] - mu) * rstd * gv[e] + bv[e]; y[4 * q + e] = v; o[e] = v; }
      *(f32x4*)(p.out + (size_t)t * 1024 + c) = o;
    }
    if (l == 0) {
      const float* m1 = (const float*)(p.ws + OFF_MOD) + (size_t)(9 + tok_modrow(t)) * 6144;
      ln_stats16(y, mu, rstd);
#pragma unroll
      for (int hh = 0; hh < 2; ++hh) {
        const int c = cb + 8 * hh;
        f32x4 sh0 = *(const f32x4*)(m1 + c), sh1 = *(const f32x4*)(m1 + c + 4), sc0 = *(const f32x4*)(m1 + 1024 + c), sc1 = *(const f32x4*)(m1 + 1024 + c + 4);
        float hv[8];
#pragma unroll
        for (int e = 0; e < 4; ++e) {
          hv[e] = (y[8 * hh + e] - mu) * rstd * (1.f + sc0[e]) + sh0[e];
          hv[4 + e] = (y[8 * hh + 4 + e] - mu) * rstd * (1.f + sc1[e]) + sh1[e];
        }
        u32x4 o = {pk2(hv[0], hv[1]), pk2(hv[2], hv[3]), pk2(hv[4], hv[5]), pk2(hv[6], hv[7])};
        *(u32x4*)(H + (size_t)t * HP + c) = o;
      }
    }
  }
}

#define XB_TMO      128
#define XB_XCNT(j)  (256  + 64 * (j))
#define XB_XSUB(j)  (1280 + 64 * (j))
#define XB_XGEN(j)  (2304 + 64 * (j))
#define XB_TOP      3328
#define XB_TOPGEN   3392
#define XCD_BAR_WORDS 3456
#define XB_SPIN_CAP (1u << 18)
#define LAS __attribute__((address_space(3)))
__device__ __forceinline__ unsigned xb_ld(unsigned* p)              { return __hip_atomic_load(p, __ATOMIC_RELAXED, __HIP_MEMORY_SCOPE_AGENT); }
__device__ __forceinline__ unsigned xb_add(unsigned* p, unsigned v) { return __hip_atomic_fetch_add(p, v, __ATOMIC_RELAXED, __HIP_MEMORY_SCOPE_AGENT); }
__device__ __forceinline__ unsigned xb_xcc_id() { return (unsigned)__builtin_amdgcn_s_getreg((3 << 11) | 20) & 0xFu; }
#define XB_SPIN(cond, bar) do { unsigned _sp = 0; while (cond) { __builtin_amdgcn_s_sleep(1); \
    if ((++_sp & 255u) == 0u) { if (xb_ld(&(bar)[XB_TMO])) break; if (_sp > XB_SPIN_CAP) { atomicAdd(&(bar)[XB_TMO], 1u); break; } } } } while (0)
struct XcdBarrier { unsigned* bar; unsigned x; volatile LAS unsigned* st; };
__device__ __forceinline__ XcdBarrier xcd_barrier_post(unsigned* bar, volatile LAS unsigned* st) {
    XcdBarrier b; b.bar = bar; b.x = xb_xcc_id(); b.st = st;
    if (threadIdx.x == 0) (void)xb_add(&bar[XB_XCNT(b.x)], 1u);
    return b;
}
__device__ __forceinline__ void xcd_barrier_complete(unsigned* bar, unsigned x, unsigned& nloc, unsigned& nx) {
    const unsigned G = gridDim.x * gridDim.y * gridDim.z;
    unsigned sum, cnt, mine, sp = 0u;
    for (;;) {
        sum = 0u; cnt = 0u; mine = 0u;
#pragma unroll
        for (unsigned j = 0; j < 16; ++j) { const unsigned c = xb_ld(&bar[XB_XCNT(j)]); sum += c; cnt += (c > 0u) ? 1u : 0u; mine = (j == x) ? c : mine; }
        if (sum == G) break;
        __builtin_amdgcn_s_sleep(1);
        if ((++sp & 255u) == 0u) { if (xb_ld(&bar[XB_TMO])) break; if (sp > XB_SPIN_CAP) { atomicAdd(&bar[XB_TMO], 1u); break; } }
    }
    nloc = mine > 0u ? mine : 1u; nx = cnt > 0u ? cnt : 1u;
}
__device__ __forceinline__ void xcd_barrier(const XcdBarrier& b) {
    asm volatile("s_waitcnt vmcnt(0)" ::: "memory");
    __syncthreads();
    if (threadIdx.x == 0) {
        unsigned* bar = b.bar;
        __builtin_amdgcn_s_waitcnt(0);
        unsigned nloc = b.st[0], nx = b.st[1];
        if (nloc == 0u) { xcd_barrier_complete(bar, b.x, nloc, nx); b.st[0] = nloc; b.st[1] = nx; }
        const unsigned old = xb_add(&bar[XB_XSUB(b.x)], 1u);
        const unsigned gen = old / nloc;
        if (old + 1u == (gen + 1u) * nloc) {
            __builtin_amdgcn_fence(__ATOMIC_RELEASE, "agent");
            asm volatile("s_waitcnt vmcnt(0)" ::: "memory");
            const unsigned og = xb_add(&bar[XB_TOP], 1u);
            const unsigned tg = og / nx;
            if (og + 1u == (tg + 1u) * nx) xb_add(&bar[XB_TOPGEN], 1u);
            else XB_SPIN(xb_ld(&bar[XB_TOPGEN]) == tg, bar);
            __builtin_amdgcn_fence(__ATOMIC_ACQUIRE, "agent");
            xb_add(&bar[XB_XGEN(b.x)], 1u);
            asm volatile("s_waitcnt vmcnt(0)" ::: "memory");
        } else {
            XB_SPIN(xb_ld(&bar[XB_XGEN(b.x)]) == gen, bar);
            __builtin_amdgcn_fence(__ATOMIC_ACQUIRE, "agent");
            asm volatile("s_waitcnt vmcnt(0)" ::: "memory");
        }
    }
    __syncthreads();
}

constexpr int NPHASE = 2 + 2 * 9;
#ifndef PH_MASK
#define PH_MASK 2047
#endif
#ifndef PH_TWICE
#define PH_TWICE 0
#endif
__global__ void __launch_bounds__(256, 3) fwd_megakernel(Params p, int ph_lo, int ph_hi) {
  __shared__ __attribute__((aligned(16))) char smem[SMEM_BYTES];
  cg::grid_group grid = cg::this_grid();
  __shared__ uint4 xb_words;
  if (threadIdx.x == 0) xb_words = make_uint4(0u, 0u, 0u, 0u);
  __syncthreads();
  const XcdBarrier xb = xcd_barrier_post((unsigned*)(p.ws + OFF_BAR), (volatile LAS unsigned*)&xb_words);
  if (ph_lo < 0) grid.sync();
#define RUN_PH(ph, mask, call) { const int ph_ = (ph); if (ph_ >= ph_lo && ph_ < ph_hi) { if (ph_ > ph_lo) xcd_barrier(xb); if (PH_MASK & (mask)) { call; } if (PH_TWICE & (mask)) { xcd_barrier(xb); call; } } }
  RUN_PH(0, 1, prep_phase(p, smem));
  RUN_PH(1, 2, s0_phase(p));
  for (int l = 0; l < 2; ++l) {
    const int b = 2 + 9 * l;
    RUN_PH(b + 0, 4, g1_phase(p, l, smem));
    RUN_PH(b + 1, 8, r1_phase(p, l, smem));
    RUN_PH(b + 2, 16, mid_phase(p, l, smem));
    RUN_PH(b + 3, 32, attn_phase(p, smem));
    RUN_PH(b + 4, 64, g4_phase(p, l, smem));
    RUN_PH(b + 5, 128, r2_phase(p, l));
    RUN_PH(b + 6, 256, g5_phase(p, l, smem));
    RUN_PH(b + 7, 1024, sel_phase(p, l, smem));
    RUN_PH(b + 8, 512, e_phase(p, l, smem));
  }
}

#ifndef MULTI_LAUNCH
#define MULTI_LAUNCH 0
#endif

extern "C" void kernel_launch(void* const* d_in, const int* in_sizes, int n_in, void* d_out, int out_size, void* d_ws, size_t ws_size,
                              hipStream_t stream) {
  (void)in_sizes; (void)n_in; (void)out_size;
  if (ws_size < WS_NEED) { fprintf(stderr, "workspace too small: %zu < %zu\n", ws_size, (size_t)WS_NEED); return; }
  Params p{};
  const float** pp = (const float**)&p;
  for (int i = 0; i < 29; ++i) pp[i] = (const float*)d_in[i];
  p.out = (float*)d_out; p.ws = (char*)d_ws;
  static int grid_blocks = 0;
  if (!grid_blocks) {
    int dev = 0, cus = 0, per_cu = 0;
    hipGetDevice(&dev);
    hipDeviceGetAttribute(&cus, hipDeviceAttributeMultiprocessorCount, dev);
    hipOccupancyMaxActiveBlocksPerMultiprocessor(&per_cu, fwd_megakernel, 256, 0);
    if (per_cu < 1) per_cu = 1;
    grid_blocks = cus * per_cu;
  }
  hipMemsetAsync((char*)d_ws + OFF_MOD, 0, SZ_MOD + SZ_BAR, stream);
#if MULTI_LAUNCH
  for (int ph = 0; ph < NPHASE; ++ph) {
    int lo = ph, hi = ph + 1;
    hipLaunchKernelGGL(fwd_megakernel, dim3(grid_blocks), dim3(256), 0, stream, p, lo, hi);
  }
#else
  int lo = 0, hi = NPHASE;
  void* args[] = {&p, &lo, &hi};
  hipError_t e = hipLaunchCooperativeKernel((void*)fwd_megakernel, dim3(grid_blocks), dim3(256), args, 0, stream);
  if (e != hipSuccess) fprintf(stderr, "cooperative launch failed: %s (grid %d)\n", hipGetErrorString(e), grid_blocks);
#endif
}
```
